# Optimizing an MI355X kernel written in HIP

```python
import math
import jax, jax.numpy as jnp
from jax import lax
import numpy as np

D_MODEL = 1024
BATCH = 8
SEQ = 2048
DEPTH = 2

N_MIXERS = 2
N_A = (DEPTH + 1) // 2
N_B = DEPTH // 2

HY_ORDER = 2
HY_STREAMS = HY_ORDER + 1
HY_EMB = 33
HY_BANDS = (HY_EMB - 1) // 2
HY_FILT = 64
HY_DECAY_TARGET = 1e-2
HY_FAST_DECAY = 0.3
HY_SLOW_DECAY = 1.5
HY_FILTER_OUT_SCALE = 0.05

HEAD_DIM = 64
N_HEADS = D_MODEL // HEAD_DIM
N_KV = N_HEADS // 4
GROUP = N_HEADS // N_KV
WINDOW = 128
BLOCK = 128
ROT_DIM = HEAD_DIM // 4
ROPE_THETA = 500000.0

D_FF = 4 * D_MODEL
EPS = 1e-6
NEG = -1e30

kernel_name = "hybrid_hyena_swa_sandwich_encoder"


def rms_norm(x, g):
    xf = x.astype(jnp.float32)
    y = xf * lax.rsqrt(jnp.mean(xf * xf, axis=-1, keepdims=True) + EPS)
    return (y * g.astype(jnp.float32)).astype(x.dtype)


def short_conv(u, w, b):
    L = u.shape[1]
    up = jnp.pad(u, ((0, 0), (1, 1), (0, 0)))
    return up[:, :L] * w[0] + up[:, 1:L + 1] * w[1] + up[:, 2:] * w[2] + b


def hyena_filters(L, f_w1, f_b1, f_w2, f_b2, f_w3, f_b3, f_freq, f_wout):
    f32 = jnp.float32
    t = jnp.linspace(0.0, 1.0, L, dtype=f32)[:, None]
    w = (2.0 * math.pi / L) * jnp.arange(L, dtype=f32)[:, None]
    f = jnp.linspace(1e-4, HY_BANDS - 1, HY_BANDS, dtype=f32)[None, :]
    z = jnp.concatenate([t, jnp.cos(f * w), -jnp.sin(f * w)], axis=-1)
    freq = f_freq.astype(f32)
    h = jnp.sin(freq * (z @ f_w1.astype(f32) + f_b1.astype(f32)))
    h = jnp.sin(freq * (h @ f_w2.astype(f32) + f_b2.astype(f32)))
    h = jnp.sin(freq * (h @ f_w3.astype(f32) + f_b3.astype(f32)))
    h = (h @ f_wout.astype(f32)).reshape(L, 2, HY_ORDER, D_MODEL)
    max_decay = math.log(HY_DECAY_TARGET) / HY_FAST_DECAY
    min_decay = math.log(HY_DECAY_TARGET) / HY_SLOW_DECAY
    deltas = jnp.linspace(min_decay, max_decay, D_MODEL, dtype=f32)
    decay = jnp.exp(-t * jnp.abs(deltas)[None, :])
    return h * decay[:, None, None, :]


def long_conv(u, k_hat, bias):
    L = u.shape[1]
    u_hat = jnp.fft.rfft(u, n=2 * L, axis=1)
    y = jnp.fft.irfft(u_hat * k_hat[None], n=2 * L, axis=1)[:, :L]
    return y + u * bias


def hyena_mixer(x, w_in, conv_w, conv_b, f_w1, f_b1, f_w2, f_b2, f_w3, f_b3,
                f_freq, f_wout, bias, w_out):
    f32 = jnp.float32
    B, L, _ = x.shape
    u = (x @ w_in).astype(f32)
    u = short_conv(u, conv_w.astype(f32), conv_b.astype(f32))
    v, x1, x2 = jnp.split(u, HY_STREAMS, axis=-1)
    h = hyena_filters(L, f_w1, f_b1, f_w2, f_b2, f_w3, f_b3, f_freq, f_wout)
    k_full = jnp.concatenate(
        [h[:, 0], jnp.zeros((1, HY_ORDER, D_MODEL), f32), h[:0:-1, 1]], axis=0)
    k_hat = jnp.fft.rfft(k_full, axis=0)
    bias = bias.astype(f32)
    gates = (x1, x2)
    z = v
    for n in range(HY_ORDER):
        z = gates[n] * long_conv(z, k_hat[:, n], bias[n])
    return z.astype(x.dtype) @ w_out


def rope_partial(t, pos):
    f32 = jnp.float32
    half = ROT_DIM // 2
    inv = ROPE_THETA ** (-jnp.arange(0, ROT_DIM, 2, dtype=f32) / ROT_DIM)
    ang = pos.astype(f32)[:, None] * inv[None, :]
    cos = jnp.cos(ang)[None, :, None, :]
    sin = jnp.sin(ang)[None, :, None, :]
    tr = t[..., :ROT_DIM].astype(f32)
    a, b = tr[..., :half], tr[..., half:]
    rot = jnp.concatenate([a * cos - b * sin, b * cos + a * sin], axis=-1)
    return jnp.concatenate([rot.astype(t.dtype), t[..., ROT_DIM:]], axis=-1)


def window_attention(x, w_qkv, sink, w_o):
    f32 = jnp.float32
    B, S, _ = x.shape
    nb = S // BLOCK
    qkv = x @ w_qkv
    q, k, v = jnp.split(qkv, [N_HEADS * HEAD_DIM, (N_HEADS + N_KV) * HEAD_DIM], axis=-1)
    q = q.reshape(B, S, N_HEADS, HEAD_DIM)
    k = k.reshape(B, S, N_KV, HEAD_DIM)
    v = v.reshape(B, S, N_KV, HEAD_DIM)
    pos = jnp.arange(S)
    q = rope_partial(q, pos)
    k = rope_partial(k, pos)
    qb = q.reshape(B, nb, BLOCK, N_KV, GROUP, HEAD_DIM).astype(f32)

    def band(t):
        tp = jnp.pad(t, ((0, 0), (BLOCK, BLOCK), (0, 0), (0, 0)))
        tp = tp.reshape(B, nb + 2, BLOCK, N_KV, HEAD_DIM)
        return jnp.concatenate([tp[:, :-2], tp[:, 1:-1], tp[:, 2:]], axis=2).astype(f32)

    kb, vb = band(k), band(v)
    s = jnp.einsum('bnqhgd,bnkhd->bnhgqk', qb, kb) * (HEAD_DIM ** -0.5)
    qpos = jnp.arange(nb)[:, None] * BLOCK + jnp.arange(BLOCK)[None, :]
    kpos = jnp.arange(nb)[:, None] * BLOCK - BLOCK + jnp.arange(3 * BLOCK)[None, :]
    rel = kpos[:, None, :] - qpos[:, :, None]
    valid = (jnp.abs(rel) <= WINDOW) & (kpos[:, None, :] >= 0) & (kpos[:, None, :] < S)
    s = jnp.where(valid[None, :, None, None, :, :], s, NEG)
    sink_l = sink.astype(f32).reshape(1, 1, N_KV, GROUP, 1, 1)
    sink_b = jnp.broadcast_to(sink_l, s.shape[:-1] + (1,))
    p = jax.nn.softmax(jnp.concatenate([s, sink_b], axis=-1), axis=-1)[..., :-1]
    o = jnp.einsum('bnhgqk,bnkhd->bnqhgd', p, vb)
    o = o.reshape(B, S, N_HEADS * HEAD_DIM).astype(x.dtype)
    return o @ w_o


def squared_relu_mlp(x, w_up, w_down):
    return jnp.square(jax.nn.relu(x @ w_up)) @ w_down


def setup_inputs(seed: int = 0) -> dict:
    key = jax.random.key(seed)
    ks = jax.random.split(key, 32)
    f32 = jnp.float32
    D = D_MODEL

    def nrm(k, shape, scale):
        return jax.random.normal(k, shape, f32) * scale

    def gain(k, shape):
        return 1.0 + 0.05 * jax.random.normal(k, shape, f32)

    return {
        "x": jax.random.normal(ks[0], (BATCH, SEQ, D), f32),
        "norm_mix_pre": gain(ks[1], (DEPTH, D)),
        "norm_mix_post": gain(ks[2], (DEPTH, D)),
        "norm_mlp_pre": gain(ks[3], (DEPTH, D)),
        "norm_mlp_post": gain(ks[4], (DEPTH, D)),
        "w_up": nrm(ks[5], (DEPTH, D, D_FF), D ** -0.5),
        "w_down": nrm(ks[6], (DEPTH, D_FF, D), D_FF ** -0.5),
        "hy_w_in": nrm(ks[7], (N_A, D, HY_STREAMS * D), D ** -0.5),
        "hy_conv_w": nrm(ks[8], (N_A, 3, HY_STREAMS * D), 3 ** -0.5),
        "hy_conv_b": nrm(ks[9], (N_A, HY_STREAMS * D), 0.02),
        "hy_f_w1": nrm(ks[10], (N_A, HY_EMB, HY_FILT), HY_EMB ** -0.5),
        "hy_f_b1": nrm(ks[11], (N_A, HY_FILT), 0.1),
        "hy_f_w2": nrm(ks[12], (N_A, HY_FILT, HY_FILT), HY_FILT ** -0.5),
        "hy_f_b2": nrm(ks[13], (N_A, HY_FILT), 0.1),
        "hy_f_w3": nrm(ks[14], (N_A, HY_FILT, HY_FILT), HY_FILT ** -0.5),
        "hy_f_b3": nrm(ks[15], (N_A, HY_FILT), 0.1),
        "hy_f_freq": gain(ks[16], (N_A, HY_FILT)),
        "hy_f_wout": nrm(ks[17], (N_A, HY_FILT, 2 * HY_ORDER * D), HY_FILTER_OUT_SCALE * HY_FILT ** -0.5),
        "hy_bias": nrm(ks[18], (N_A, HY_ORDER, D), 0.1),
        "hy_w_out": nrm(ks[19], (N_A, D, D), D ** -0.5),
        "at_w_qkv": nrm(ks[20], (N_B, D, (N_HEADS + 2 * N_KV) * HEAD_DIM), D ** -0.5),
        "at_sink": nrm(ks[21], (N_B, N_HEADS), 0.5),
        "at_w_o": nrm(ks[22], (N_B, N_HEADS * HEAD_DIM, D), (N_HEADS * HEAD_DIM) ** -0.5),
    }


def reference(x, norm_mix_pre, norm_mix_post, norm_mlp_pre, norm_mlp_post, w_up, w_down,
              hy_w_in, hy_conv_w, hy_conv_b, hy_f_w1, hy_f_b1, hy_f_w2, hy_f_b2, hy_f_w3,
              hy_f_b3, hy_f_freq, hy_f_wout, hy_bias, hy_w_out, at_w_qkv, at_sink, at_w_o):
    h = x
    for i in range(DEPTH):
        hn = rms_norm(h, norm_mix_pre[i])
        j = i // N_MIXERS
        if i % N_MIXERS == 0:
            m = hyena_mixer(hn, hy_w_in[j], hy_conv_w[j], hy_conv_b[j], hy_f_w1[j], hy_f_b1[j],
                            hy_f_w2[j], hy_f_b2[j], hy_f_w3[j], hy_f_b3[j], hy_f_freq[j],
                            hy_f_wout[j], hy_bias[j], hy_w_out[j])
        else:
            m = window_attention(hn, at_w_qkv[j], at_sink[j], at_w_o[j])
        h = h + rms_norm(m, norm_mix_post[i])
        hn = rms_norm(h, norm_mlp_pre[i])
        h = h + rms_norm(squared_relu_mlp(hn, w_up[i], w_down[i]), norm_mlp_post[i])
    return h
```

```cpp
#include <hip/hip_runtime.h>
#include <hip/hip_cooperative_groups.h>
#include <cstdio>
#include <cstdint>
namespace cg = cooperative_groups;

namespace pg8 {
#define PG8_LAS __attribute__((address_space(3)))
typedef unsigned short bf16_t;
typedef short bf16x8 __attribute__((ext_vector_type(8)));
typedef float f32x4 __attribute__((ext_vector_type(4)));
typedef unsigned u32x4 __attribute__((ext_vector_type(4)));
constexpr int BM = 256, BK = 64, HALF = 128, HTB = HALF * BK * 2  , STAGE_BYTES = 8 * HTB, NXCD = 8, WGM = 8;

__host__ __device__ __forceinline__ int lds_byte(int r, int c) { const int st = (r >> 4) * 2 + (c >> 5), rr = r & 15, cc = c & 31, ob = rr * 64 + cc * 2; return st * 1024 + (ob ^ (((ob >> 9) & 1) << 5)); }
__host__ __device__ __forceinline__ void stage_rc(int b, int& R, int& C) { const int st = b / 1024, sb = b % 1024, swz = sb ^ (((sb >> 9) & 1) << 5); R = (st >> 1) * 16 + swz / 64; C = (st & 1) * 32 + (swz % 64) / 2; }
__host__ __device__ __forceinline__ int perm32(int rho) { const int n = rho >> 4, i = rho & 15; return 8 * (i >> 2) + 4 * n + (i & 3); }

struct Unit { int pm, pn; };
struct Gemm { const bf16_t* A; const bf16_t* Bt; int M, N, K; };

struct StaticOrder {
    int nM, nN, nwg, G, c;
    __host__ __device__ void init(int M, int N, int G_, int c_) { nM = M / BM; nN = N / BM; nwg = nM * nN; G = G_; c = c_; }
    __host__ __device__ bool next(int i, Unit& u) const {
        const long L = (long)i * G + c; if (L >= nwg) return false;
        int wgid = (int)L; { const int q = nwg / NXCD, r = nwg % NXCD, xcd = wgid % NXCD, off = wgid / NXCD; wgid = (xcd < r ? xcd * (q + 1) : r * (q + 1) + (xcd - r) * q) + off; }
        const int nig = WGM * nN, gid = wgid / nig, fm = gid * WGM, gsz = (nM - fm) < WGM ? (nM - fm) : WGM;
        u.pm = fm + ((wgid % nig) % gsz); u.pn = (wgid % nig) / gsz; return true;
    }
    __device__ __forceinline__ void a_ready(const Unit&) const {}
    __device__ __forceinline__ void done(const Unit&) const {}
};

__device__ __forceinline__ unsigned cvt_pk_bf16(float lo, float hi) { unsigned r; asm volatile("v_cvt_pk_bf16_f32 %0, %1, %2" : "=v"(r) : "v"(lo), "v"(hi)); return r; }

template <int ACT  > struct EpiBf16 {
    static constexpr bool PERM = true, AFTER_DRAIN = false;
    bf16_t* O; int ldc;
    __device__ __forceinline__ void operator()(const f32x4 (&acc)[2][2][4][2], const Unit& u, int wr, int wc, int fr, int fq) const {
        const int row0 = u.pm * BM + wr * 64 + fr; const int col0 = u.pn * BM + wc * 32 + 8 * fq;
#pragma unroll
        for (int ai = 0; ai < 2; ++ai)
#pragma unroll
            for (int m = 0; m < 4; ++m) { bf16_t* rowp = O + (size_t)(row0 + ai * HALF + m * 16) * ldc + col0;
#pragma unroll
                for (int bj = 0; bj < 2; ++bj) { f32x4 v0 = acc[ai][bj][m][0], v1 = acc[ai][bj][m][1];
                    if (ACT == 2) {
#pragma unroll
                        for (int e = 0; e < 4; ++e) { const float a = fmaxf(v0[e], 0.f), b = fmaxf(v1[e], 0.f); v0[e] = a * a; v1[e] = b * b; } }
                    u32x4 w; w.x = cvt_pk_bf16(v0[0], v0[1]); w.y = cvt_pk_bf16(v0[2], v0[3]); w.z = cvt_pk_bf16(v1[0], v1[1]); w.w = cvt_pk_bf16(v1[2], v1[3]);
                    *(u32x4*)(rowp + bj * HALF) = w; } }
    }
};

template <class Epi, class Sched, bool ALIGN_EPI = false, bool SP2 = false>
__device__ __forceinline__ void gemm_phase(PG8_LAS unsigned char* lds, const Gemm g, const Sched& S, const Epi& E) {
    int tid_ = threadIdx.x; asm volatile("" : "+v"(tid_));
    const int tid = tid_, wid = __builtin_amdgcn_readfirstlane(tid >> 6), lane = tid & 63, wr = wid >> 2, wc = wid & 3, fr = lane & 15, fq = lane >> 4;
    const int K = g.K, nt = K / BK;
    unsigned voffA[2], voffB[2];
#pragma unroll
    for (int i = 0; i < 2; ++i) { int R, C; stage_rc(tid * 16 + i * 8192, R, C); const int Rb = Epi::PERM ? ((R & ~31) + perm32(R & 31)) : R;
        voffA[i] = (unsigned)(R * K + C) * 2u; voffB[i] = (unsigned)(Rb * K + C) * 2u; }
    const size_t kstep = (size_t)(BK * 2);
    const size_t hstep = (size_t)HALF * K * 2;
    const size_t tstep = 2 * hstep;
    const unsigned ldsw = (unsigned)wid * 1024u;
    const int aoff = lds_byte(wr * 64 + fr, fq * 8), boff = lds_byte(wc * 32 + fr, fq * 8);
#define PG8_SA(b, h) (((b) * 2 + (h)) * HTB)
#define PG8_SB(b, h) ((4 + (b) * 2 + (h)) * HTB)
#define PG8_STAGE(bufoff, gbase, voff) do { _Pragma("unroll") for (int _i = 0; _i < 2; ++_i) \
        __builtin_amdgcn_global_load_lds((const unsigned*)((const char*)(gbase) + (voff)[_i]), (PG8_LAS unsigned*)(lds + (bufoff) + ldsw + _i * 8192), 16, 0, 0); } while (0)
#define PG8_LDA(dst, b, h) do { _Pragma("unroll") for (int m = 0; m < 4; ++m) _Pragma("unroll") for (int k = 0; k < 2; ++k) dst[m][k] = *(const PG8_LAS bf16x8*)(lds + PG8_SA(b, h) + aoff + m * 2048 + k * 1024); } while (0)
#define PG8_LDB(dst, b, h) do { _Pragma("unroll") for (int n = 0; n < 2; ++n) _Pragma("unroll") for (int k = 0; k < 2; ++k) dst[n][k] = *(const PG8_LAS bf16x8*)(lds + PG8_SB(b, h) + boff + n * 2048 + k * 1024); } while (0)
#define PG8_MMA(ai, bj, At, Bt) do { __builtin_amdgcn_s_setprio(1); _Pragma("unroll") for (int m = 0; m < 4; ++m) _Pragma("unroll") for (int n = 0; n < 2; ++n) _Pragma("unroll") for (int k = 0; k < 2; ++k) \
        acc[ai][bj][m][n] = __builtin_amdgcn_mfma_f32_16x16x32_bf16(Bt[n][k], At[m][k], acc[ai][bj][m][n], 0, 0, 0); __builtin_amdgcn_s_setprio(0); } while (0)
#define PG8_WAIT_V(n) asm volatile("s_waitcnt vmcnt(" #n ")" ::: "memory")
#define PG8_WAIT_L(n) asm volatile("s_waitcnt lgkmcnt(" #n ")" ::: "memory")
#define PG8_BAR __builtin_amdgcn_s_barrier()
#define PG8_SCHED __builtin_amdgcn_sched_barrier(0)
    Unit cur, nxt; int ui = 0;
    if (!S.next(0, cur)) return;
    f32x4 acc[2][2][4][2];
#pragma unroll
    for (int a = 0; a < 2; ++a)
#pragma unroll
        for (int b = 0; b < 2; ++b)
#pragma unroll
            for (int m = 0; m < 4; ++m)
#pragma unroll
                for (int n = 0; n < 2; ++n) acc[a][b][m][n] = (f32x4){0.f, 0.f, 0.f, 0.f};
    bf16x8 At[4][2], B0[2][2], B1[2][2];
    const char* cA = (const char*)g.A + (size_t)cur.pm * tstep; const char* cB = (const char*)g.Bt + (size_t)cur.pn * tstep;
    S.a_ready(cur);
    if constexpr (SP2) {
        PG8_STAGE(PG8_SB(0, 0), cB, voffB); PG8_STAGE(PG8_SB(0, 1), cB + hstep, voffB); PG8_STAGE(PG8_SA(0, 0), cA, voffA); PG8_STAGE(PG8_SA(0, 1), cA + hstep, voffA);
        if (wr == 1) PG8_BAR;
        PG8_WAIT_V(2); PG8_BAR;
        PG8_STAGE(PG8_SB(1, 0), cB + kstep, voffB); PG8_STAGE(PG8_SA(1, 0), cA + kstep, voffA); PG8_STAGE(PG8_SB(1, 1), cB + hstep + kstep, voffB);
        PG8_WAIT_V(6); PG8_BAR;
    } else {
        PG8_STAGE(PG8_SB(0, 0), cB, voffB); PG8_STAGE(PG8_SA(0, 0), cA, voffA); PG8_STAGE(PG8_SB(0, 1), cB + hstep, voffB); PG8_STAGE(PG8_SA(0, 1), cA + hstep, voffA);
        if (wr == 1) PG8_BAR;
        PG8_WAIT_V(4); PG8_BAR;
        PG8_STAGE(PG8_SB(1, 0), cB + kstep, voffB); PG8_STAGE(PG8_SA(1, 0), cA + kstep, voffA); PG8_STAGE(PG8_SB(1, 1), cB + hstep + kstep, voffB);
        PG8_WAIT_V(6); PG8_BAR;
    }
    for (;;) {
        const bool has_next = S.next(ui + 1, nxt);
        const char* nA = has_next ? (const char*)g.A + (size_t)nxt.pm * tstep : cA; const char* nB = has_next ? (const char*)g.Bt + (size_t)nxt.pn * tstep : cB;
        for (int t = 0; t < nt; t += 2) {
            const bool last = (t == nt - 2);
            const char* a1 = cA + (size_t)(t + 1) * kstep;
            const char* a2 = last ? nA : cA + (size_t)(t + 2) * kstep; const char* b2 = last ? nB : cB + (size_t)(t + 2) * kstep;
            const char* a3 = a2 + kstep; const char* b3 = b2 + kstep;
            if (last && has_next) S.a_ready(nxt);
            if constexpr (SP2) {
            PG8_LDB(B0, 0, 0); PG8_LDB(B1, 0, 1); PG8_SCHED; PG8_LDA(At, 0, 0); PG8_STAGE(PG8_SA(1, 1), a1 + hstep, voffA);
            PG8_WAIT_V(8); PG8_WAIT_L(0); PG8_BAR; PG8_MMA(0, 0, At, B0); PG8_MMA(0, 1, At, B1); PG8_BAR; PG8_SCHED;
            PG8_LDA(At, 0, 1); PG8_STAGE(PG8_SB(0, 0), b2, voffB); PG8_STAGE(PG8_SB(0, 1), b2 + hstep, voffB); PG8_STAGE(PG8_SA(0, 0), a2, voffA);
            PG8_WAIT_V(8); PG8_WAIT_L(0); PG8_BAR; PG8_MMA(1, 0, At, B0); PG8_MMA(1, 1, At, B1); PG8_BAR; PG8_SCHED;
            PG8_LDB(B0, 1, 0); PG8_LDB(B1, 1, 1); PG8_SCHED; PG8_LDA(At, 1, 0); PG8_STAGE(PG8_SA(0, 1), a2 + hstep, voffA);
            PG8_WAIT_V(8); PG8_WAIT_L(0); PG8_BAR; PG8_MMA(0, 0, At, B0); PG8_MMA(0, 1, At, B1); PG8_BAR; PG8_SCHED;
            PG8_LDA(At, 1, 1); PG8_STAGE(PG8_SB(1, 0), b3, voffB); PG8_STAGE(PG8_SB(1, 1), b3 + hstep, voffB); PG8_STAGE(PG8_SA(1, 0), a3, voffA);
            PG8_WAIT_V(8); PG8_WAIT_L(0); PG8_BAR; PG8_MMA(1, 0, At, B0); PG8_MMA(1, 1, At, B1); PG8_BAR; PG8_SCHED;
            } else {
            PG8_LDB(B0, 0, 0); PG8_SCHED; PG8_LDA(At, 0, 0); PG8_STAGE(PG8_SA(1, 1), a1 + hstep, voffA);
            PG8_WAIT_L(8); PG8_BAR; PG8_WAIT_L(0); PG8_MMA(0, 0, At, B0); PG8_BAR; PG8_SCHED;
            PG8_LDB(B1, 0, 1); PG8_STAGE(PG8_SB(0, 0), b2, voffB);
            PG8_BAR; PG8_WAIT_L(0); PG8_MMA(0, 1, At, B1); PG8_BAR;
            PG8_LDA(At, 0, 1); PG8_STAGE(PG8_SA(0, 0), a2, voffA);
            PG8_BAR; PG8_WAIT_L(0); PG8_MMA(1, 0, At, B0); PG8_BAR; PG8_SCHED;
            PG8_STAGE(PG8_SB(0, 1), b2 + hstep, voffB);
            PG8_WAIT_V(6); PG8_BAR; PG8_MMA(1, 1, At, B1); PG8_BAR;
            PG8_LDB(B0, 1, 0); PG8_SCHED; PG8_LDA(At, 1, 0); PG8_STAGE(PG8_SA(0, 1), a2 + hstep, voffA);
            PG8_WAIT_L(8); PG8_BAR; PG8_WAIT_L(0); PG8_MMA(0, 0, At, B0); PG8_BAR; PG8_SCHED;
            PG8_LDB(B1, 1, 1); PG8_STAGE(PG8_SB(1, 0), b3, voffB);
            PG8_BAR; PG8_WAIT_L(0); PG8_MMA(0, 1, At, B1); PG8_BAR;
            PG8_LDA(At, 1, 1); PG8_STAGE(PG8_SA(1, 0), a3, voffA);
            PG8_BAR; PG8_WAIT_L(0); PG8_MMA(1, 0, At, B0); PG8_BAR; PG8_SCHED;
            PG8_STAGE(PG8_SB(1, 1), b3 + hstep, voffB);
            PG8_WAIT_V(6); PG8_BAR; PG8_MMA(1, 1, At, B1); PG8_BAR;
            }
        }
        if constexpr (ALIGN_EPI) { if (wr == 0) PG8_BAR; }
        if constexpr (!Epi::AFTER_DRAIN) { E(acc, cur, wr, wc, fr, fq); S.done(cur); }
        if (!has_next) break;
#pragma unroll
        for (int a = 0; a < 2; ++a)
#pragma unroll
            for (int b = 0; b < 2; ++b)
#pragma unroll
                for (int m = 0; m < 4; ++m)
#pragma unroll
                    for (int n = 0; n < 2; ++n) acc[a][b][m][n] = (f32x4){0.f, 0.f, 0.f, 0.f};
        cur = nxt; cA = nA; cB = nB; ++ui;
        if constexpr (ALIGN_EPI) { if (wr == 1) PG8_BAR; }
    }
    PG8_WAIT_V(0);
    if constexpr (!ALIGN_EPI) { if (wr == 0) PG8_BAR; }
    PG8_BAR;
    if constexpr (Epi::AFTER_DRAIN) { E.fused(acc, cur, wr, wc, fr, fq, lds, wid, lane); S.done(cur); }
#undef PG8_SA
#undef PG8_SB
#undef PG8_STAGE
#undef PG8_LDA
#undef PG8_LDB
#undef PG8_MMA
#undef PG8_WAIT_V
#undef PG8_WAIT_L
#undef PG8_BAR
#undef PG8_SCHED
}
}

#define GAS __attribute__((address_space(1)))
#define LAS __attribute__((address_space(3)))
typedef unsigned short bf16;
typedef unsigned v4u __attribute__((ext_vector_type(4)));
typedef unsigned v2u __attribute__((ext_vector_type(2)));
typedef float f32x4 __attribute__((ext_vector_type(4)));
typedef float f32x16 __attribute__((ext_vector_type(16)));
typedef short bf16x8 __attribute__((ext_vector_type(8)));
#define LDS_WAIT() asm volatile("s_waitcnt lgkmcnt(0)" ::: "memory")

constexpr int NWAVES = 8, NTHR = 512;
constexpr int BATCH = 8, SEQ = 2048, D = 1024, M = BATCH * SEQ, FF = 4096, NQKV = 1536, D3 = 3 * D;
constexpr float EPS = 1e-6f;
constexpr size_t MiB = 1u << 20;
constexpr size_t WS_WIN = 2 * MiB, WS_WHO = 8 * MiB, WS_WUP0 = 10 * MiB, WS_WUP1 = 18 * MiB, WS_WDN0 = 26 * MiB, WS_WDN1 = 34 * MiB, WS_WQKV = 42 * MiB, WS_WO = 45 * MiB;
constexpr size_t WS_ROPE = 47 * MiB;
constexpr size_t WS_KG = 48 * MiB;
constexpr size_t WS_XN = 64 * MiB;
constexpr size_t WS_MX = 96 * MiB;
constexpr size_t WS_BIG = 128 * MiB;
constexpr size_t WS_UT = WS_BIG, WS_Z = WS_BIG + 96 * MiB, WS_QKV = WS_BIG, WS_O = WS_BIG + 48 * MiB, WS_HB = WS_BIG;
constexpr size_t WS_END = 256 * MiB;
constexpr int LDS_BYTES = 147456;

__device__ __forceinline__ unsigned f2bf(float f) { unsigned u = __builtin_bit_cast(unsigned, f); return (u + 0x7fffu + ((u >> 16) & 1u)) >> 16; }
__device__ __forceinline__ unsigned pk2(float lo, float hi) { return f2bf(lo) | (f2bf(hi) << 16); }
__device__ __forceinline__ float bflo(unsigned w) { return __builtin_bit_cast(float, w << 16); }
__device__ __forceinline__ float bfhi(unsigned w) { return __builtin_bit_cast(float, w & 0xffff0000u); }
__device__ __forceinline__ float bf2f(unsigned short h) { return __builtin_bit_cast(float, (unsigned)h << 16); }
__device__ __forceinline__ float wave_sum(float v) {
#pragma unroll
    for (int o = 1; o < 64; o <<= 1) v += __shfl_xor(v, o);
    return v;
}

__device__ __forceinline__ float hw_sin(float x) { float r = x * 0.15915494309189535f; r -= floorf(r); return __builtin_amdgcn_sinf(r); }
__device__ __forceinline__ float hw_cos(float x) { float r = x * 0.15915494309189535f; r -= floorf(r); return __builtin_amdgcn_cosf(r); }
struct Frame {
    LAS unsigned char* lds;
    int tid, lane, wave, vcu, G;
};

__device__ __forceinline__ Frame relaunder(const Frame& F0) { Frame F = F0; int t = threadIdx.x; asm volatile("" : "+v"(t)); F.tid = t; F.lane = t & 63; F.wave = __builtin_amdgcn_readfirstlane(t >> 6); return F; }
__device__ __forceinline__ void p0_transpose_item(const float* W, int K, int N, bf16* WT, LAS float* scr, int item, int lane) {
    const int nblk = N / 32, kb = item / nblk, nb = item % nblk, k0 = 64 * kb, n0 = 32 * nb;
#pragma unroll 8
    for (int i = 0; i < 32; ++i) { const int kk = 2 * i + (lane >> 5); scr[kk * 33 + (lane & 31)] = W[(size_t)(k0 + kk) * N + n0 + (lane & 31)]; }
    LDS_WAIT(); asm volatile("" ::: "memory");
    const int c = lane & 7;
#pragma unroll
    for (int j = 0; j < 4; ++j) { const int n = (lane >> 3) + 8 * j; const LAS float* s = scr + (8 * c) * 33 + n;
        v4u o; o.x = pk2(s[0 * 33], s[1 * 33]); o.y = pk2(s[2 * 33], s[3 * 33]); o.z = pk2(s[4 * 33], s[5 * 33]); o.w = pk2(s[6 * 33], s[7 * 33]);
        *(GAS v4u*)(WT + (size_t)(n0 + n) * K + k0 + 8 * c) = o; }
    LDS_WAIT(); asm volatile("" ::: "memory");
}

__device__ __forceinline__ void rms_row_to_bf16(int lane, const float* xrow, const float* g, bf16* orow) {
    f32x4 v[2][2]; float s = 0.f;
#pragma unroll
    for (int j = 0; j < 2; ++j)
#pragma unroll
        for (int h = 0; h < 2; ++h) { v[j][h] = *(const GAS f32x4*)(xrow + 512 * j + 8 * lane + 4 * h); s += (v[j][h].x * v[j][h].x + v[j][h].y * v[j][h].y) + (v[j][h].z * v[j][h].z + v[j][h].w * v[j][h].w); }
    const float rstd = 1.f / sqrtf(wave_sum(s) * (1.f / D) + EPS);
#pragma unroll
    for (int j = 0; j < 2; ++j) {
        const f32x4 g0 = *(const GAS f32x4*)(g + 512 * j + 8 * lane), g1 = *(const GAS f32x4*)(g + 512 * j + 8 * lane + 4);
        const f32x4 a = v[j][0] * rstd * g0, b = v[j][1] * rstd * g1;
        v4u o; o.x = pk2(a.x, a.y); o.y = pk2(a.z, a.w); o.z = pk2(b.x, b.y); o.w = pk2(b.z, b.w);
        *(GAS v4u*)(orow + 512 * j + 8 * lane) = o; }
}

__device__ __forceinline__ void norm_pass(const Frame& F0, const float* res_in, float* res_out, const bf16* mx, const float* gpost, const float* gpre, bf16* xn) {
    const Frame F = relaunder(F0);
    const int gw = F.vcu * NWAVES + F.wave, NGW = F.G * NWAVES, lane = F.lane;
    for (int row = gw; row < M; row += NGW) {
        f32x4 mv[2][2], rv[2][2]; float s = 0.f;
#pragma unroll
        for (int j = 0; j < 2; ++j) {
            const v4u w = *(const GAS v4u*)(mx + (size_t)row * D + 512 * j + 8 * lane);
            mv[j][0] = (f32x4){bflo(w.x), bfhi(w.x), bflo(w.y), bfhi(w.y)}; mv[j][1] = (f32x4){bflo(w.z), bfhi(w.z), bflo(w.w), bfhi(w.w)};
#pragma unroll
            for (int h = 0; h < 2; ++h) { rv[j][h] = *(const GAS f32x4*)(res_in + (size_t)row * D + 512 * j + 8 * lane + 4 * h);
                s += (mv[j][h].x * mv[j][h].x + mv[j][h].y * mv[j][h].y) + (mv[j][h].z * mv[j][h].z + mv[j][h].w * mv[j][h].w); }
        }
        const float rstd = 1.f / sqrtf(wave_sum(s) * (1.f / D) + EPS);
        float s2 = 0.f;
#pragma unroll
        for (int j = 0; j < 2; ++j)
#pragma unroll
            for (int h = 0; h < 2; ++h) { const f32x4 g = *(const GAS f32x4*)(gpost + 512 * j + 8 * lane + 4 * h);
                const f32x4 hv = rv[j][h] + mv[j][h] * rstd * g; rv[j][h] = hv;
                *(GAS f32x4*)(res_out + (size_t)row * D + 512 * j + 8 * lane + 4 * h) = hv;
                s2 += (hv.x * hv.x + hv.y * hv.y) + (hv.z * hv.z + hv.w * hv.w); }
        if (xn) {
            const float rstd2 = 1.f / sqrtf(wave_sum(s2) * (1.f / D) + EPS);
#pragma unroll
            for (int j = 0; j < 2; ++j) {
                const f32x4 g0 = *(const GAS f32x4*)(gpre + 512 * j + 8 * lane), g1 = *(const GAS f32x4*)(gpre + 512 * j + 8 * lane + 4);
                const f32x4 a = rv[j][0] * rstd2 * g0, b = rv[j][1] * rstd2 * g1;
                v4u o; o.x = pk2(a.x, a.y); o.y = pk2(a.z, a.w); o.z = pk2(b.x, b.y); o.w = pk2(b.z, b.w);
                *(GAS v4u*)(xn + (size_t)row * D + 512 * j + 8 * lane) = o; }
        }
    }
}

__device__ __forceinline__ void filter_gen(const Frame& F0, const float* w1, const float* b1, const float* w2, const float* b2, const float* w3, const float* b3,
                                           const float* freq, const float* wout, bf16* KG) {
    const Frame F = relaunder(F0);
    LAS float* zf = (LAS float*)F.lds;
    LAS float* ha = zf + 8 * 36;
    LAS float* hb = ha + 8 * 64;
    LAS float* h3 = hb + 8 * 64;
    const int tid = F.tid;
    for (int tile = blockIdx.x; tile < SEQ / 8; tile += F.G) {
        const int t0 = tile * 8;
        if (tid < 8 * 33) { const int tt = tid / 33, e = tid % 33, t = t0 + tt; float v;
            if (e == 0) v = (float)t / (float)(SEQ - 1);
            else { const int bi = (e - 1) & 15; const float f = 1e-4f + (float)bi * ((15.0f - 1e-4f) / 15.0f); const float w = (6.283185307179586f / (float)SEQ) * (float)t; const float a = f * w;
                v = (e <= 16) ? hw_cos(a) : -hw_sin(a); }
            zf[tt * 36 + e] = v; }
        __syncthreads();
        const int tt = tid >> 6, k = tid & 63; const float fr = freq[k];
        { float s = b1[k];
#pragma unroll 3
          for (int e = 0; e < 33; ++e) s += zf[tt * 36 + e] * w1[e * 64 + k]; ha[tt * 64 + k] = hw_sin(fr * s); }
        __syncthreads();
        { float s = b2[k];
#pragma unroll 4
          for (int e = 0; e < 64; ++e) s += ha[tt * 64 + e] * w2[e * 64 + k]; hb[tt * 64 + k] = hw_sin(fr * s); }
        __syncthreads();
        { float s = b3[k];
#pragma unroll 4
          for (int e = 0; e < 64; ++e) s += hb[tt * 64 + e] * w3[e * 64 + k]; h3[k * 8 + tt] = hw_sin(fr * s); }
        __syncthreads();
        const float min_decay = -3.0701134573253945f, max_decay = -15.350567286626972f;
#pragma unroll 1
        for (int q = 0; q < 8; ++q) {
            const int col = tid + 512 * q;
            float acc[8];
#pragma unroll
            for (int i = 0; i < 8; ++i) acc[i] = 0.f;
#pragma unroll 4
            for (int kk = 0; kk < 64; ++kk) { const float w = wout[(size_t)kk * 4096 + col]; const f32x4 a = *(const LAS f32x4*)(h3 + kk * 8), b = *(const LAS f32x4*)(h3 + kk * 8 + 4);
                acc[0] += w * a.x; acc[1] += w * a.y; acc[2] += w * a.z; acc[3] += w * a.w; acc[4] += w * b.x; acc[5] += w * b.y; acc[6] += w * b.z; acc[7] += w * b.w; }
            const int dir = col >> 11, order = (col >> 10) & 1, c = col & 1023;
            const float delta = fabsf(min_decay + (max_decay - min_decay) * ((float)c / (float)(D - 1)));
            unsigned short hv[8];
#pragma unroll
            for (int i = 0; i < 8; ++i) { const float tn = (float)(t0 + i) / (float)(SEQ - 1); hv[i] = (unsigned short)f2bf(acc[i] * __expf(-tn * delta)); }
            bf16* dst = KG + (size_t)(order * 1024 + c) * 4096;
            if (dir == 0) {
#pragma unroll
                for (int i = 0; i < 8; ++i) dst[2048 - (t0 + i)] = hv[i];
            } else if (t0 == 0) {
                dst[0] = 0;
#pragma unroll
                for (int i = 1; i < 8; ++i) dst[2048 + i] = hv[i];
            } else {
                v4u o; o.x = hv[0] | ((unsigned)hv[1] << 16); o.y = hv[2] | ((unsigned)hv[3] << 16); o.z = hv[4] | ((unsigned)hv[5] << 16); o.w = hv[6] | ((unsigned)hv[7] << 16);
                *(GAS v4u*)(dst + 2048 + t0) = o;
            }
        }
        __syncthreads();
    }
}

constexpr int UPB = 4880;
constexpr int CV_UB = 0, CV_XB = 8 * UPB, CV_KF = CV_XB + 8 * 4096, KFS = 8224, CV_END = CV_KF + 8 * KFS;
static_assert(CV_END <= LDS_BYTES, "conv LDS map");

__device__ __forceinline__ void cv_stage_stream(const Frame& F, const bf16* src, float w0, float w1, float w2, float bb, LAS unsigned char* dst, int rs, int eo) {
#pragma unroll
    for (int j = 0; j < 4; ++j) {
        const int id = F.tid + 512 * j, b = id >> 8, t8 = (id & 255) * 8;
        const bf16* p = src + b * 2048 + t8;
        const v4u w = *(const GAS v4u*)p;
        const float prev = (t8 > 0) ? bf2f(p[-1]) : 0.f, next = (t8 + 8 < 2048) ? bf2f(p[8]) : 0.f;
        float u[10]; u[0] = prev; u[1] = bflo(w.x); u[2] = bfhi(w.x); u[3] = bflo(w.y); u[4] = bfhi(w.y); u[5] = bflo(w.z); u[6] = bfhi(w.z); u[7] = bflo(w.w); u[8] = bfhi(w.w); u[9] = next;
        float o[8];
#pragma unroll
        for (int i = 0; i < 8; ++i) o[i] = w0 * u[i] + w1 * u[i + 1] + w2 * u[i + 2] + bb;
        v4u r; r.x = pk2(o[0], o[1]); r.y = pk2(o[2], o[3]); r.z = pk2(o[4], o[5]); r.w = pk2(o[6], o[7]);
        *(LAS v4u*)(dst + b * rs + (eo + t8) * 2) = r;
    }
}
__device__ __forceinline__ void cv_stage_filter(const Frame& F, const bf16* kg) {
    const int w = F.tid;
    v4u lo = (v4u){0u, 0u, 0u, 0u}, hi4;
    if (w > 0) lo = *(const GAS v4u*)(kg + 8 * (w - 1));
    hi4 = *(const GAS v4u*)(kg + 8 * w);
    const unsigned Dw[8] = {lo.x, lo.y, lo.z, lo.w, hi4.x, hi4.y, hi4.z, hi4.w};
    LAS unsigned char* base = F.lds + CV_KF + w * 16;
#pragma unroll
    for (int q = 0; q < 8; ++q) {
        v4u o;
        if ((q & 1) == 0) { const int s = (8 - q) / 2; o.x = Dw[s & 7]; o.y = Dw[(s + 1) & 7]; o.z = Dw[(s + 2) & 7]; o.w = Dw[(s + 3) & 7]; }
        else { const int s = (7 - q) / 2;
            o.x = __builtin_amdgcn_alignbit(Dw[s + 1], Dw[s], 16); o.y = __builtin_amdgcn_alignbit(Dw[s + 2], Dw[s + 1], 16);
            o.z = __builtin_amdgcn_alignbit(Dw[s + 3], Dw[s + 2], 16); o.w = __builtin_amdgcn_alignbit(Dw[s + 4], Dw[s + 3], 16); }
        *(LAS v4u*)(base + q * KFS) = o;
    }
}
__device__ __forceinline__ void cv_mfma_loop(const Frame& F, f32x16 (&acc)[2]) {
    const int lane = F.lane, hi = lane >> 5, i = lane & 31, tau = F.wave;
    const int d0 = 4 * tau - 31;
    unsigned aaddr = CV_KF + (i & 7) * KFS + (256 + hi - (i >> 3)) * 16 - 128 * d0;
    unsigned baddr = CV_UB + (i & 7) * UPB + (192 + 64 * (4 * tau + (i >> 3)) + 8 * hi) * 2 - 128 * d0;
#pragma unroll
    for (int e = 0; e < 16; ++e) { acc[0][e] = 0.f; acc[1][e] = 0.f; }
    for (int s = 0; s < 35; ++s) {
        bf16x8 Af[6], Bf[4];
#pragma unroll
        for (int u = 0; u < 6; ++u) Af[u] = *(const LAS bf16x8*)(F.lds + aaddr + 32 * (u - 2));
#pragma unroll
        for (int ks = 0; ks < 4; ++ks) Bf[ks] = *(const LAS bf16x8*)(F.lds + baddr + 32 * ks);
#pragma unroll
        for (int ks = 0; ks < 4; ++ks) {
            acc[0] = __builtin_amdgcn_mfma_f32_32x32x16_bf16(Af[ks + 2], Bf[ks], acc[0], 0, 0, 0);
            acc[1] = __builtin_amdgcn_mfma_f32_32x32x16_bf16(Af[ks], Bf[ks], acc[1], 0, 0, 0);
        }
        aaddr -= 128; baddr -= 128;
    }
}

__device__ __forceinline__ void conv_phase(const Frame& F0, const bf16* UT, const bf16* KG, const float* cw, const float* cb, const float* hbias, bf16* Z) {
    const Frame F = relaunder(F0);
    const int lane = F.lane, hi = lane >> 5, n = lane & 31, r = n >> 3, b = n & 7, tau = F.wave;
    for (int o = F.tid * 16; o < 8 * UPB; o += NTHR * 16) *(LAS v4u*)(F.lds + CV_UB + o) = (v4u){0u, 0u, 0u, 0u};
    __syncthreads();
    for (int vg = F.vcu; vg < D / 4; vg += F.G) {
        unsigned zo[2][4][4][2];
#pragma unroll
        for (int a = 0; a < 2; ++a)
#pragma unroll
            for (int g = 0; g < 4; ++g)
#pragma unroll
                for (int e = 0; e < 4; ++e) { zo[a][g][e][0] = 0u; zo[a][g][e][1] = 0u; }
        for (int cc = 0; cc < 4; ++cc) {
            const int c = vg * 4 + cc;
            cv_stage_stream(F, UT + (size_t)c * M, cw[c], cw[D3 + c], cw[2 * D3 + c], cb[c], F.lds + CV_UB, UPB, 192);
            cv_stage_stream(F, UT + (size_t)(D + c) * M, cw[D + c], cw[D3 + D + c], cw[2 * D3 + D + c], cb[D + c], F.lds + CV_XB, 4096, 0);
            cv_stage_filter(F, KG + (size_t)c * 4096);
            __syncthreads();
            f32x16 acc[2];
            cv_mfma_loop(F, acc);
            const float bias0 = hbias[c], bias1 = hbias[D + c];
            v2u zt[2][4];
#pragma unroll
            for (int mi = 0; mi < 2; ++mi)
#pragma unroll
                for (int g = 0; g < 4; ++g) {
                    const int t = 64 * (4 * tau + r) + 32 * mi + 8 * g + 4 * hi;
                    const v2u vv = *(const LAS v2u*)(F.lds + CV_UB + b * UPB + (192 + t) * 2), xx = *(const LAS v2u*)(F.lds + CV_XB + b * 4096 + t * 2);
                    const float z0 = bflo(xx.x) * (acc[mi][4 * g + 0] + bias0 * bflo(vv.x)), z1 = bfhi(xx.x) * (acc[mi][4 * g + 1] + bias0 * bfhi(vv.x));
                    const float z2 = bflo(xx.y) * (acc[mi][4 * g + 2] + bias0 * bflo(vv.y)), z3 = bfhi(xx.y) * (acc[mi][4 * g + 3] + bias0 * bfhi(vv.y));
                    zt[mi][g].x = pk2(z0, z1); zt[mi][g].y = pk2(z2, z3);
                }
            __syncthreads();
#pragma unroll
            for (int mi = 0; mi < 2; ++mi)
#pragma unroll
                for (int g = 0; g < 4; ++g) { const int t = 64 * (4 * tau + r) + 32 * mi + 8 * g + 4 * hi; *(LAS v2u*)(F.lds + CV_UB + b * UPB + (192 + t) * 2) = zt[mi][g]; }
            cv_stage_stream(F, UT + (size_t)(2 * D + c) * M, cw[2 * D + c], cw[D3 + 2 * D + c], cw[2 * D3 + 2 * D + c], cb[2 * D + c], F.lds + CV_XB, 4096, 0);
            cv_stage_filter(F, KG + (size_t)(D + c) * 4096);
            __syncthreads();
            cv_mfma_loop(F, acc);
#pragma unroll
            for (int mi = 0; mi < 2; ++mi)
#pragma unroll
                for (int g = 0; g < 4; ++g) {
                    const int t = 64 * (4 * tau + r) + 32 * mi + 8 * g + 4 * hi;
                    const v2u vv = *(const LAS v2u*)(F.lds + CV_UB + b * UPB + (192 + t) * 2), xx = *(const LAS v2u*)(F.lds + CV_XB + b * 4096 + t * 2);
                    float z[4];
                    z[0] = bflo(xx.x) * (acc[mi][4 * g + 0] + bias1 * bflo(vv.x)); z[1] = bfhi(xx.x) * (acc[mi][4 * g + 1] + bias1 * bfhi(vv.x));
                    z[2] = bflo(xx.y) * (acc[mi][4 * g + 2] + bias1 * bflo(vv.y)); z[3] = bfhi(xx.y) * (acc[mi][4 * g + 3] + bias1 * bfhi(vv.y));
#pragma unroll
                    for (int e = 0; e < 4; ++e) {
                        const unsigned hb16 = f2bf(z[e]);
                        const unsigned sh = (cc & 1) ? (hb16 << 16) : hb16;
                        const unsigned m0 = zo[mi][g][e][0] | sh, m1 = zo[mi][g][e][1] | sh;
                        zo[mi][g][e][0] = (cc < 2) ? m0 : zo[mi][g][e][0];
                        zo[mi][g][e][1] = (cc < 2) ? zo[mi][g][e][1] : m1;
                    }
                }
            __syncthreads();
        }
#pragma unroll
        for (int mi = 0; mi < 2; ++mi)
#pragma unroll
            for (int g = 0; g < 4; ++g)
#pragma unroll
                for (int e = 0; e < 4; ++e) {
                    const int t = 64 * (4 * tau + r) + 32 * mi + 8 * g + 4 * hi + e;
                    v2u o; o.x = zo[mi][g][e][0]; o.y = zo[mi][g][e][1];
                    *(GAS v2u*)(Z + (size_t)(b * SEQ + t) * D + vg * 4) = o;
                }
    }
}

constexpr int KROW = 144, VROW = 784, AT_K = 0, AT_V = 384 * KROW, AT_END = AT_V + 64 * VROW;
static_assert(AT_END <= LDS_BYTES, "attention LDS map");

__device__ __forceinline__ void attn_phase(const Frame& F0, const bf16* QKV, const float* rope, const float* sink, bf16* O) {
    const Frame F = relaunder(F0);
    const int lane = F.lane, hi = lane >> 5, iq = lane & 31, w = F.wave, g = w >> 1, half = w & 1;
    for (int u = blockIdx.x; u < BATCH * 16 * 4; u += F.G) {
        const int kvh = u & 3, nb = (u >> 2) & 15, bb = u >> 6;
#pragma unroll
        for (int j = 0; j < 3; ++j) {
            const int id = F.tid + 512 * j, key = id >> 2, p = id & 3;
            const int kpos = (nb - 1) * 128 + key;
            v4u c0 = (v4u){0u, 0u, 0u, 0u}, c1 = c0;
            if (kpos >= 0 && kpos < SEQ) {
                const bf16* src = QKV + (size_t)(bb * SEQ + kpos) * NQKV + 1024 + kvh * 64 + 16 * p;
                c0 = *(const GAS v4u*)src; c1 = *(const GAS v4u*)(src + 8);
                if (p == 0) {
                    const f32x4 cA = *(const GAS f32x4*)(rope + kpos * 16), cB = *(const GAS f32x4*)(rope + kpos * 16 + 4), sA = *(const GAS f32x4*)(rope + kpos * 16 + 8), sB = *(const GAS f32x4*)(rope + kpos * 16 + 12);
                    const float cs[8] = {cA.x, cA.y, cA.z, cA.w, cB.x, cB.y, cB.z, cB.w}, sn[8] = {sA.x, sA.y, sA.z, sA.w, sB.x, sB.y, sB.z, sB.w};
                    const unsigned aw[4] = {c0.x, c0.y, c0.z, c0.w}, bw[4] = {c1.x, c1.y, c1.z, c1.w};
                    unsigned ao[4], bo[4];
#pragma unroll
                    for (int e = 0; e < 4; ++e) {
                        const float a0 = bflo(aw[e]), a1 = bfhi(aw[e]), b0 = bflo(bw[e]), b1 = bfhi(bw[e]);
                        ao[e] = pk2(a0 * cs[2 * e] - b0 * sn[2 * e], a1 * cs[2 * e + 1] - b1 * sn[2 * e + 1]);
                        bo[e] = pk2(b0 * cs[2 * e] + a0 * sn[2 * e], b1 * cs[2 * e + 1] + a1 * sn[2 * e + 1]);
                    }
                    c0 = (v4u){ao[0], ao[1], ao[2], ao[3]}; c1 = (v4u){bo[0], bo[1], bo[2], bo[3]};
                }
            }
            *(LAS v4u*)(F.lds + AT_K + key * KROW + 32 * p) = c0; *(LAS v4u*)(F.lds + AT_K + key * KROW + 32 * p + 16) = c1;
        }
#pragma unroll
        for (int j = 0; j < 6; ++j) {
            const int id = F.tid + 512 * j, key = id % 384, ch = id / 384;
            const int kpos = (nb - 1) * 128 + key;
            v4u c0 = (v4u){0u, 0u, 0u, 0u};
            if (kpos >= 0 && kpos < SEQ) c0 = *(const GAS v4u*)(QKV + (size_t)(bb * SEQ + kpos) * NQKV + 1280 + kvh * 64 + 8 * ch);
            const unsigned cw4[4] = {c0.x, c0.y, c0.z, c0.w};
#pragma unroll
            for (int e = 0; e < 4; ++e) {
                *(LAS unsigned short*)(F.lds + AT_V + (8 * ch + 2 * e) * VROW + key * 2) = (unsigned short)(cw4[e] & 0xffffu);
                *(LAS unsigned short*)(F.lds + AT_V + (8 * ch + 2 * e + 1) * VROW + key * 2) = (unsigned short)(cw4[e] >> 16);
            }
        }
        __syncthreads();
        const int hq = kvh * 4 + g;
        const float sk = sink[hq];
#pragma unroll 1
        for (int qt = 0; qt < 2; ++qt) {
            const int qi = 64 * half + 32 * qt + iq, qpos = nb * 128 + qi;
            const bf16* qsrc = QKV + (size_t)(bb * SEQ + qpos) * NQKV + hq * 64;
            bf16x8 Qf[4];
            {
                const v4u ca = *(const GAS v4u*)qsrc, cbv = *(const GAS v4u*)(qsrc + 8);
                const f32x4 cA = *(const GAS f32x4*)(rope + qpos * 16), cB = *(const GAS f32x4*)(rope + qpos * 16 + 4), sA = *(const GAS f32x4*)(rope + qpos * 16 + 8), sB = *(const GAS f32x4*)(rope + qpos * 16 + 12);
                const float cs[8] = {cA.x, cA.y, cA.z, cA.w, cB.x, cB.y, cB.z, cB.w}, sn[8] = {sA.x, sA.y, sA.z, sA.w, sB.x, sB.y, sB.z, sB.w};
                const unsigned aw[4] = {ca.x, ca.y, ca.z, ca.w}, bw[4] = {cbv.x, cbv.y, cbv.z, cbv.w};
                unsigned oo[4];
#pragma unroll
                for (int e = 0; e < 4; ++e) {
                    const float a0 = bflo(aw[e]), a1 = bfhi(aw[e]), b0 = bflo(bw[e]), b1 = bfhi(bw[e]);
                    const float r0 = hi ? (b0 * cs[2 * e] + a0 * sn[2 * e]) : (a0 * cs[2 * e] - b0 * sn[2 * e]);
                    const float r1 = hi ? (b1 * cs[2 * e + 1] + a1 * sn[2 * e + 1]) : (a1 * cs[2 * e + 1] - b1 * sn[2 * e + 1]);
                    oo[e] = pk2(r0, r1);
                }
                Qf[0] = __builtin_bit_cast(bf16x8, (v4u){oo[0], oo[1], oo[2], oo[3]});
            }
#pragma unroll
            for (int ks = 1; ks < 4; ++ks) Qf[ks] = *(const GAS bf16x8*)(qsrc + 16 * ks + 8 * hi);
            f32x16 Oa[2];
#pragma unroll
            for (int e = 0; e < 16; ++e) { Oa[0][e] = 0.f; Oa[1][e] = 0.f; }
            float mrun = sk, lrun = hi ? 0.f : 1.f;
            const int kt0 = 2 * half + qt;
#pragma unroll 1
            for (int j = 0; j < 9; ++j) {
                const int kt = kt0 + j;
                if ((nb == 0 && kt < 4) || (nb == 15 && kt >= 8)) continue;
                f32x16 S;
#pragma unroll
                for (int e = 0; e < 16; ++e) S[e] = 0.f;
#pragma unroll
                for (int ks = 0; ks < 4; ++ks) {
                    const bf16x8 Kf = *(const LAS bf16x8*)(F.lds + AT_K + (32 * kt + iq) * KROW + (16 * ks + 8 * hi) * 2);
                    S = __builtin_amdgcn_mfma_f32_32x32x16_bf16(Kf, Qf[ks], S, 0, 0, 0);
                }
                float tmax = -3.0e38f;
#pragma unroll
                for (int e = 0; e < 16; ++e) {
                    const int jj = 8 * (e >> 2) + 4 * hi + (e & 3);
                    float s = S[e] * 0.125f;
                    if (j == 0 && jj < iq) s = -3.0e38f;
                    if (j == 8 && jj > iq) s = -3.0e38f;
                    S[e] = s; tmax = fmaxf(tmax, s);
                }
                tmax = fmaxf(tmax, __shfl_xor(tmax, 32));
                const float mnew = fmaxf(mrun, tmax), alpha = __expf(mrun - mnew);
                float ps = 0.f;
#pragma unroll
                for (int e = 0; e < 16; ++e) { const float p = __expf(S[e] - mnew); S[e] = p; ps += p; }
                lrun = lrun * alpha + ps; mrun = mnew;
#pragma unroll
                for (int e = 0; e < 16; ++e) { Oa[0][e] *= alpha; Oa[1][e] *= alpha; }
#pragma unroll
                for (int s2 = 0; s2 < 2; ++s2) {
                    const bf16x8 Pf = __builtin_bit_cast(bf16x8, (v4u){pk2(S[8 * s2 + 0], S[8 * s2 + 1]), pk2(S[8 * s2 + 2], S[8 * s2 + 3]), pk2(S[8 * s2 + 4], S[8 * s2 + 5]), pk2(S[8 * s2 + 6], S[8 * s2 + 7])});
#pragma unroll
                    for (int mt = 0; mt < 2; ++mt) {
                        const LAS unsigned char* vp = F.lds + AT_V + (32 * mt + iq) * VROW + (32 * kt + 16 * s2 + 4 * hi) * 2;
                        const v2u v0 = *(const LAS v2u*)vp, v1 = *(const LAS v2u*)(vp + 16);
                        const bf16x8 Vf = __builtin_bit_cast(bf16x8, (v4u){v0.x, v0.y, v1.x, v1.y});
                        Oa[mt] = __builtin_amdgcn_mfma_f32_32x32x16_bf16(Vf, Pf, Oa[mt], 0, 0, 0);
                    }
                }
            }
            const float ltot = lrun + __shfl_xor(lrun, 32), inv = 1.f / ltot;
            bf16* orow = O + (size_t)(bb * SEQ + qpos) * D + hq * 64;
#pragma unroll
            for (int mt = 0; mt < 2; ++mt)
#pragma unroll
                for (int gq = 0; gq < 4; ++gq) {
                    v2u o; o.x = pk2(Oa[mt][4 * gq + 0] * inv, Oa[mt][4 * gq + 1] * inv); o.y = pk2(Oa[mt][4 * gq + 2] * inv, Oa[mt][4 * gq + 3] * inv);
                    *(GAS v2u*)(orow + 32 * mt + 8 * gq + 4 * hi) = o;
                }
        }
        __syncthreads();
    }
}

struct Args { const float* in[23]; float* out; unsigned char* ws; };
__global__ void __launch_bounds__(NTHR, 2) hybrid_fwd(Args args) {
    extern __shared__ __attribute__((aligned(16))) unsigned char lds_raw[];
    cg::grid_group grid = cg::this_grid();
    Frame F;
    F.lds = (LAS unsigned char*)lds_raw;
    F.tid = threadIdx.x; F.lane = F.tid & 63; F.wave = __builtin_amdgcn_readfirstlane(F.tid >> 6);
    F.G = gridDim.x; { const int bx = blockIdx.x; F.vcu = (F.G % 8 == 0) ? (bx % 8) * (F.G / 8) + bx / 8 : bx; }
    unsigned char* ws = args.ws;
    const float* x = args.in[0];
    const float *g_mix_pre = args.in[1], *g_mix_post = args.in[2], *g_mlp_pre = args.in[3], *g_mlp_post = args.in[4];
    bf16 *Wt_in = (bf16*)(ws + WS_WIN), *Wt_ho = (bf16*)(ws + WS_WHO), *Wt_up0 = (bf16*)(ws + WS_WUP0), *Wt_up1 = (bf16*)(ws + WS_WUP1), *Wt_dn0 = (bf16*)(ws + WS_WDN0), *Wt_dn1 = (bf16*)(ws + WS_WDN1),
         *Wt_qkv = (bf16*)(ws + WS_WQKV), *Wt_o = (bf16*)(ws + WS_WO);
    float* rope = (float*)(ws + WS_ROPE);
    bf16 *KG = (bf16*)(ws + WS_KG), *XN = (bf16*)(ws + WS_XN), *MX = (bf16*)(ws + WS_MX), *UT = (bf16*)(ws + WS_UT), *Zb = (bf16*)(ws + WS_Z), *QKV = (bf16*)(ws + WS_QKV), *Ob = (bf16*)(ws + WS_O), *HB = (bf16*)(ws + WS_HB);
    float* hres = args.out;

#ifndef NO_FG
    filter_gen(F, args.in[10], args.in[11], args.in[12], args.in[13], args.in[14], args.in[15], args.in[16], args.in[17], KG);
#endif
    {
        const int gt = blockIdx.x * NTHR + F.tid;
        for (int id = gt; id < SEQ * 8; id += F.G * NTHR) { const int pos = id >> 3, i = id & 7;
            const float inv = __expf(-(float)i * (13.122363377404328f / 8.0f)); const float ang = (float)pos * inv;
            rope[pos * 16 + i] = hw_cos(ang); rope[pos * 16 + 8 + i] = hw_sin(ang); }
    }
    {
        LAS float* scr = (LAS float*)(F.lds + F.wave * 16384);
        const int gw = F.vcu * NWAVES + F.wave, NGW = F.G * NWAVES;
        constexpr int I_IN = 16 * 96, I_HO = 16 * 32, I_UP = 16 * 128, I_DN = 64 * 32, I_QKV = 16 * 48, I_O = 16 * 32;
        constexpr int NITEMS = I_IN + I_HO + 2 * I_UP + 2 * I_DN + I_QKV + I_O;
        for (int it = gw; it < NITEMS; it += NGW) {
            int r = it;
            if (r < I_IN) { p0_transpose_item(args.in[7], D, D3, Wt_in, scr, r, F.lane); continue; } r -= I_IN;
            if (r < I_HO) { p0_transpose_item(args.in[19], D, D, Wt_ho, scr, r, F.lane); continue; } r -= I_HO;
            if (r < I_UP) { p0_transpose_item(args.in[5], D, FF, Wt_up0, scr, r, F.lane); continue; } r -= I_UP;
            if (r < I_UP) { p0_transpose_item(args.in[5] + (size_t)D * FF, D, FF, Wt_up1, scr, r, F.lane); continue; } r -= I_UP;
            if (r < I_DN) { p0_transpose_item(args.in[6], FF, D, Wt_dn0, scr, r, F.lane); continue; } r -= I_DN;
            if (r < I_DN) { p0_transpose_item(args.in[6] + (size_t)D * FF, FF, D, Wt_dn1, scr, r, F.lane); continue; } r -= I_DN;
            if (r < I_QKV) { p0_transpose_item(args.in[20], D, NQKV, Wt_qkv, scr, r, F.lane); continue; } r -= I_QKV;
            p0_transpose_item(args.in[22], D, D, Wt_o, scr, r, F.lane);
        }
        for (int m = gw; m < M; m += NGW) rms_row_to_bf16(F.lane, x + (size_t)m * D, g_mix_pre, XN + (size_t)m * D);
    }
    grid.sync();
    { pg8::Gemm g{Wt_in, XN, D3, M, D}; pg8::StaticOrder S; S.init(D3, M, F.G, (int)blockIdx.x); pg8::EpiBf16<0> E{UT, M};
      pg8::gemm_phase<pg8::EpiBf16<0>, pg8::StaticOrder, true, true>(F.lds, g, S, E); }
    grid.sync();
#ifndef NO_CONV
    conv_phase(F, UT, KG, args.in[8], args.in[9], args.in[18], Zb);
#endif
    grid.sync();
    { pg8::Gemm g{Zb, Wt_ho, M, D, D}; pg8::StaticOrder S; S.init(M, D, F.G, (int)blockIdx.x); pg8::EpiBf16<0> E{MX, D};
      pg8::gemm_phase<pg8::EpiBf16<0>, pg8::StaticOrder, true, true>(F.lds, g, S, E); }
    grid.sync();
    norm_pass(F, x, hres, MX, g_mix_post, g_mlp_pre, XN);
    grid.sync();
    { pg8::Gemm g{XN, Wt_up0, M, FF, D}; pg8::StaticOrder S; S.init(M, FF, F.G, (int)blockIdx.x); pg8::EpiBf16<2> E{HB, FF};
      pg8::gemm_phase<pg8::EpiBf16<2>, pg8::StaticOrder, true, true>(F.lds, g, S, E); }
    grid.sync();
    { pg8::Gemm g{HB, Wt_dn0, M, D, FF}; pg8::StaticOrder S; S.init(M, D, F.G, (int)blockIdx.x); pg8::EpiBf16<0> E{MX, D};
      pg8::gemm_phase<pg8::EpiBf16<0>, pg8::StaticOrder, true, true>(F.lds, g, S, E); }
    grid.sync();
    norm_pass(F, hres, hres, MX, g_mlp_post, g_mix_pre + D, XN);
    grid.sync();
    { pg8::Gemm g{XN, Wt_qkv, M, NQKV, D}; pg8::StaticOrder S; S.init(M, NQKV, F.G, (int)blockIdx.x); pg8::EpiBf16<0> E{QKV, NQKV};
      pg8::gemm_phase<pg8::EpiBf16<0>, pg8::StaticOrder, true, true>(F.lds, g, S, E); }
    grid.sync();
#ifndef NO_ATTN
    attn_phase(F, QKV, rope, args.in[21], Ob);
#endif
    grid.sync();
    { pg8::Gemm g{Ob, Wt_o, M, D, D}; pg8::StaticOrder S; S.init(M, D, F.G, (int)blockIdx.x); pg8::EpiBf16<0> E{MX, D};
      pg8::gemm_phase<pg8::EpiBf16<0>, pg8::StaticOrder, true, true>(F.lds, g, S, E); }
    grid.sync();
    norm_pass(F, hres, hres, MX, g_mix_post + D, g_mlp_pre + D, XN);
    grid.sync();
    { pg8::Gemm g{XN, Wt_up1, M, FF, D}; pg8::StaticOrder S; S.init(M, FF, F.G, (int)blockIdx.x); pg8::EpiBf16<2> E{HB, FF};
      pg8::gemm_phase<pg8::EpiBf16<2>, pg8::StaticOrder, true, true>(F.lds, g, S, E); }
    grid.sync();
    { pg8::Gemm g{HB, Wt_dn1, M, D, FF}; pg8::StaticOrder S; S.init(M, D, F.G, (int)blockIdx.x); pg8::EpiBf16<0> E{MX, D};
      pg8::gemm_phase<pg8::EpiBf16<0>, pg8::StaticOrder, true, true>(F.lds, g, S, E); }
    grid.sync();
    norm_pass(F, hres, hres, MX, g_mlp_post + D, nullptr, nullptr);
}

extern "C" void kernel_launch(void* const* d_in, const int* in_sizes, int n_in, void* d_out, int out_size, void* d_ws, size_t ws_size, hipStream_t stream) {
    static int grid = 0;
    if (grid == 0) {
        if (n_in != 23 || out_size != M * D || ws_size < WS_END) { fprintf(stderr, "kernel_launch: unexpected shapes (n_in %d out %d ws %zu)\n", n_in, out_size, ws_size); grid = -1; return; }
        int dev = 0, cus = 0, per_cu = 0;
        if (hipGetDevice(&dev) != hipSuccess || hipDeviceGetAttribute(&cus, hipDeviceAttributeMultiprocessorCount, dev) != hipSuccess) { grid = -1; return; }
        if (hipFuncSetAttribute((const void*)hybrid_fwd, hipFuncAttributeMaxDynamicSharedMemorySize, LDS_BYTES) != hipSuccess) { fprintf(stderr, "kernel_launch: hipFuncSetAttribute failed\n"); grid = -1; return; }
        if (hipOccupancyMaxActiveBlocksPerMultiprocessor(&per_cu, (const void*)hybrid_fwd, NTHR, LDS_BYTES) != hipSuccess || per_cu < 1) { fprintf(stderr, "kernel_launch: occupancy query says %d\n", per_cu); per_cu = 1; }
        (void)hipGetLastError();
        grid = cus * per_cu;
    }
    if (grid < 0) return;
    Args a{};
    for (int i = 0; i < 23; ++i) a.in[i] = (const float*)d_in[i];
    a.out = (float*)d_out; a.ws = (unsigned char*)d_ws;
    void* kargs[] = {&a};
    const hipError_t e = hipLaunchCooperativeKernel((const void*)hybrid_fwd, dim3(grid), dim3(NTHR), kargs, LDS_BYTES, stream);
    if (e != hipSuccess) fprintf(stderr, "kernel_launch: cooperative launch failed: %s (grid %d)\n", hipGetErrorString(e), grid);
}
```

```cpp
#include <hip/hip_runtime.h>
#include <hip/hip_cooperative_groups.h>
#include <cstdio>
#include <cstdint>
namespace cg = cooperative_groups;

namespace pg8 {
#define PG8_LAS __attribute__((address_space(3)))
typedef unsigned short bf16_t;
typedef short bf16x8 __attribute__((ext_vector_type(8)));
typedef float f32x4 __attribute__((ext_vector_type(4)));
typedef unsigned u32x4 __attribute__((ext_vector_type(4)));
constexpr int BM = 256, BK = 64, HALF = 128, HTB = HALF * BK * 2  , STAGE_BYTES = 8 * HTB, NXCD = 8, WGM = 8;

__host__ __device__ __forceinline__ int lds_byte(int r, int c) { const int st = (r >> 4) * 2 + (c >> 5), rr = r & 15, cc = c & 31, ob = rr * 64 + cc * 2; return st * 1024 + (ob ^ (((ob >> 9) & 1) << 5)); }
__host__ __device__ __forceinline__ void stage_rc(int b, int& R, int& C) { const int st = b / 1024, sb = b % 1024, swz = sb ^ (((sb >> 9) & 1) << 5); R = (st >> 1) * 16 + swz / 64; C = (st & 1) * 32 + (swz % 64) / 2; }
__host__ __device__ __forceinline__ int perm32(int rho) { const int n = rho >> 4, i = rho & 15; return 8 * (i >> 2) + 4 * n + (i & 3); }

struct Unit { int pm, pn; };
struct Gemm { const bf16_t* A; const bf16_t* Bt; int M, N, K; };

struct StaticOrder {
    int nM, nN, nwg, G, c;
    __host__ __device__ void init(int M, int N, int G_, int c_) { nM = M / BM; nN = N / BM; nwg = nM * nN; G = G_; c = c_; }
    __host__ __device__ bool next(int i, Unit& u) const {
        const long L = (long)i * G + c; if (L >= nwg) return false;
        int wgid = (int)L; { const int q = nwg / NXCD, r = nwg % NXCD, xcd = wgid % NXCD, off = wgid / NXCD; wgid = (xcd < r ? xcd * (q + 1) : r * (q + 1) + (xcd - r) * q) + off; }
        const int nig = WGM * nN, gid = wgid / nig, fm = gid * WGM, gsz = (nM - fm) < WGM ? (nM - fm) : WGM;
        u.pm = fm + ((wgid % nig) % gsz); u.pn = (wgid % nig) / gsz; return true;
    }
    __device__ __forceinline__ void a_ready(const Unit&) const {}
    __device__ __forceinline__ void done(const Unit&) const {}
};

__device__ __forceinline__ unsigned cvt_pk_bf16(float lo, float hi) { unsigned r; asm volatile("v_cvt_pk_bf16_f32 %0, %1, %2" : "=v"(r) : "v"(lo), "v"(hi)); return r; }

template <int ACT  > struct EpiBf16 {
    static constexpr bool PERM = true, AFTER_DRAIN = false;
    bf16_t* O; int ldc;
    __device__ __forceinline__ void operator()(const f32x4 (&acc)[2][2][4][2], const Unit& u, int wr, int wc, int fr, int fq) const {
        const int row0 = u.pm * BM + wr * 64 + fr; const int col0 = u.pn * BM + wc * 32 + 8 * fq;
#pragma unroll
        for (int ai = 0; ai < 2; ++ai)
#pragma unroll
            for (int m = 0; m < 4; ++m) { bf16_t* rowp = O + (size_t)(row0 + ai * HALF + m * 16) * ldc + col0;
#pragma unroll
                for (int bj = 0; bj < 2; ++bj) { f32x4 v0 = acc[ai][bj][m][0], v1 = acc[ai][bj][m][1];
                    if (ACT == 2) {
#pragma unroll
                        for (int e = 0; e < 4; ++e) { const float a = fmaxf(v0[e], 0.f), b = fmaxf(v1[e], 0.f); v0[e] = a * a; v1[e] = b * b; } }
                    u32x4 w; w.x = cvt_pk_bf16(v0[0], v0[1]); w.y = cvt_pk_bf16(v0[2], v0[3]); w.z = cvt_pk_bf16(v1[0], v1[1]); w.w = cvt_pk_bf16(v1[2], v1[3]);
                    *(u32x4*)(rowp + bj * HALF) = w; } }
    }
};

template <class Epi, class Sched, bool ALIGN_EPI = false, bool SP2 = false>
__device__ __forceinline__ void gemm_phase(PG8_LAS unsigned char* lds, const Gemm g, const Sched& S, const Epi& E) {
    int tid_ = threadIdx.x; asm volatile("" : "+v"(tid_));
    const int tid = tid_, wid = __builtin_amdgcn_readfirstlane(tid >> 6), lane = tid & 63, wr = wid >> 2, wc = wid & 3, fr = lane & 15, fq = lane >> 4;
    const int K = g.K, nt = K / BK;
    unsigned voffA[2], voffB[2];
#pragma unroll
    for (int i = 0; i < 2; ++i) { int R, C; stage_rc(tid * 16 + i * 8192, R, C); const int Rb = Epi::PERM ? ((R & ~31) + perm32(R & 31)) : R;
        voffA[i] = (unsigned)(R * K + C) * 2u; voffB[i] = (unsigned)(Rb * K + C) * 2u; }
    const size_t kstep = (size_t)(BK * 2);
    const size_t hstep = (size_t)HALF * K * 2;
    const size_t tstep = 2 * hstep;
    const unsigned ldsw = (unsigned)wid * 1024u;
    const int aoff = lds_byte(wr * 64 + fr, fq * 8), boff = lds_byte(wc * 32 + fr, fq * 8);
#define PG8_SA(b, h) (((b) * 2 + (h)) * HTB)
#define PG8_SB(b, h) ((4 + (b) * 2 + (h)) * HTB)
#define PG8_STAGE(bufoff, gbase, voff) do { _Pragma("unroll") for (int _i = 0; _i < 2; ++_i) \
        __builtin_amdgcn_global_load_lds((const unsigned*)((const char*)(gbase) + (voff)[_i]), (PG8_LAS unsigned*)(lds + (bufoff) + ldsw + _i * 8192), 16, 0, 0); } while (0)
#define PG8_LDA(dst, b, h) do { _Pragma("unroll") for (int m = 0; m < 4; ++m) _Pragma("unroll") for (int k = 0; k < 2; ++k) dst[m][k] = *(const PG8_LAS bf16x8*)(lds + PG8_SA(b, h) + aoff + m * 2048 + k * 1024); } while (0)
#define PG8_LDB(dst, b, h) do { _Pragma("unroll") for (int n = 0; n < 2; ++n) _Pragma("unroll") for (int k = 0; k < 2; ++k) dst[n][k] = *(const PG8_LAS bf16x8*)(lds + PG8_SB(b, h) + boff + n * 2048 + k * 1024); } while (0)
#define PG8_MMA(ai, bj, At, Bt) do { __builtin_amdgcn_s_setprio(1); _Pragma("unroll") for (int m = 0; m < 4; ++m) _Pragma("unroll") for (int n = 0; n < 2; ++n) _Pragma("unroll") for (int k = 0; k < 2; ++k) \
        acc[ai][bj][m][n] = __builtin_amdgcn_mfma_f32_16x16x32_bf16(Bt[n][k], At[m][k], acc[ai][bj][m][n], 0, 0, 0); __builtin_amdgcn_s_setprio(0); } while (0)
#define PG8_WAIT_V(n) asm volatile("s_waitcnt vmcnt(" #n ")" ::: "memory")
#define PG8_WAIT_L(n) asm volatile("s_waitcnt lgkmcnt(" #n ")" ::: "memory")
#define PG8_BAR __builtin_amdgcn_s_barrier()
#define PG8_SCHED __builtin_amdgcn_sched_barrier(0)
    Unit cur, nxt; int ui = 0;
    if (!S.next(0, cur)) return;
    f32x4 acc[2][2][4][2];
#pragma unroll
    for (int a = 0; a < 2; ++a)
#pragma unroll
        for (int b = 0; b < 2; ++b)
#pragma unroll
            for (int m = 0; m < 4; ++m)
#pragma unroll
                for (int n = 0; n < 2; ++n) acc[a][b][m][n] = (f32x4){0.f, 0.f, 0.f, 0.f};
    bf16x8 At[4][2], B0[2][2], B1[2][2];
    const char* cA = (const char*)g.A + (size_t)cur.pm * tstep; const char* cB = (const char*)g.Bt + (size_t)cur.pn * tstep;
    S.a_ready(cur);
    if constexpr (SP2) {
        PG8_STAGE(PG8_SB(0, 0), cB, voffB); PG8_STAGE(PG8_SB(0, 1), cB + hstep, voffB); PG8_STAGE(PG8_SA(0, 0), cA, voffA); PG8_STAGE(PG8_SA(0, 1), cA + hstep, voffA);
        if (wr == 1) PG8_BAR;
        PG8_WAIT_V(2); PG8_BAR;
        PG8_STAGE(PG8_SB(1, 0), cB + kstep, voffB); PG8_STAGE(PG8_SA(1, 0), cA + kstep, voffA); PG8_STAGE(PG8_SB(1, 1), cB + hstep + kstep, voffB);
        PG8_WAIT_V(6); PG8_BAR;
    } else {
        PG8_STAGE(PG8_SB(0, 0), cB, voffB); PG8_STAGE(PG8_SA(0, 0), cA, voffA); PG8_STAGE(PG8_SB(0, 1), cB + hstep, voffB); PG8_STAGE(PG8_SA(0, 1), cA + hstep, voffA);
        if (wr == 1) PG8_BAR;
        PG8_WAIT_V(4); PG8_BAR;
        PG8_STAGE(PG8_SB(1, 0), cB + kstep, voffB); PG8_STAGE(PG8_SA(1, 0), cA + kstep, voffA); PG8_STAGE(PG8_SB(1, 1), cB + hstep + kstep, voffB);
        PG8_WAIT_V(6); PG8_BAR;
    }
    for (;;) {
        const bool has_next = S.next(ui + 1, nxt);
        const char* nA = has_next ? (const char*)g.A + (size_t)nxt.pm * tstep : cA; const char* nB = has_next ? (const char*)g.Bt + (size_t)nxt.pn * tstep : cB;
        for (int t = 0; t < nt; t += 2) {
            const bool last = (t == nt - 2);
            const char* a1 = cA + (size_t)(t + 1) * kstep;
            const char* a2 = last ? nA : cA + (size_t)(t + 2) * kstep; const char* b2 = last ? nB : cB + (size_t)(t + 2) * kstep;
            const char* a3 = a2 + kstep; const char* b3 = b2 + kstep;
            if (last && has_next) S.a_ready(nxt);
            if constexpr (SP2) {
            PG8_LDB(B0, 0, 0); PG8_LDB(B1, 0, 1); PG8_SCHED; PG8_LDA(At, 0, 0); PG8_STAGE(PG8_SA(1, 1), a1 + hstep, voffA);
            PG8_WAIT_V(8); PG8_WAIT_L(0); PG8_BAR; PG8_MMA(0, 0, At, B0); PG8_MMA(0, 1, At, B1); PG8_BAR; PG8_SCHED;
            PG8_LDA(At, 0, 1); PG8_STAGE(PG8_SB(0, 0), b2, voffB); PG8_STAGE(PG8_SB(0, 1), b2 + hstep, voffB); PG8_STAGE(PG8_SA(0, 0), a2, voffA);
            PG8_WAIT_V(8); PG8_WAIT_L(0); PG8_BAR; PG8_MMA(1, 0, At, B0); PG8_MMA(1, 1, At, B1); PG8_BAR; PG8_SCHED;
            PG8_LDB(B0, 1, 0); PG8_LDB(B1, 1, 1); PG8_SCHED; PG8_LDA(At, 1, 0); PG8_STAGE(PG8_SA(0, 1), a2 + hstep, voffA);
            PG8_WAIT_V(8); PG8_WAIT_L(0); PG8_BAR; PG8_MMA(0, 0, At, B0); PG8_MMA(0, 1, At, B1); PG8_BAR; PG8_SCHED;
            PG8_LDA(At, 1, 1); PG8_STAGE(PG8_SB(1, 0), b3, voffB); PG8_STAGE(PG8_SB(1, 1), b3 + hstep, voffB); PG8_STAGE(PG8_SA(1, 0), a3, voffA);
            PG8_WAIT_V(8); PG8_WAIT_L(0); PG8_BAR; PG8_MMA(1, 0, At, B0); PG8_MMA(1, 1, At, B1); PG8_BAR; PG8_SCHED;
            } else {
            PG8_LDB(B0, 0, 0); PG8_SCHED; PG8_LDA(At, 0, 0); PG8_STAGE(PG8_SA(1, 1), a1 + hstep, voffA);
            PG8_WAIT_L(8); PG8_BAR; PG8_WAIT_L(0); PG8_MMA(0, 0, At, B0); PG8_BAR; PG8_SCHED;
            PG8_LDB(B1, 0, 1); PG8_STAGE(PG8_SB(0, 0), b2, voffB);
            PG8_BAR; PG8_WAIT_L(0); PG8_MMA(0, 1, At, B1); PG8_BAR;
            PG8_LDA(At, 0, 1); PG8_STAGE(PG8_SA(0, 0), a2, voffA);
            PG8_BAR; PG8_WAIT_L(0); PG8_MMA(1, 0, At, B0); PG8_BAR; PG8_SCHED;
            PG8_STAGE(PG8_SB(0, 1), b2 + hstep, voffB);
            PG8_WAIT_V(6); PG8_BAR; PG8_MMA(1, 1, At, B1); PG8_BAR;
            PG8_LDB(B0, 1, 0); PG8_SCHED; PG8_LDA(At, 1, 0); PG8_STAGE(PG8_SA(0, 1), a2 + hstep, voffA);
            PG8_WAIT_L(8); PG8_BAR; PG8_WAIT_L(0); PG8_MMA(0, 0, At, B0); PG8_BAR; PG8_SCHED;
            PG8_LDB(B1, 1, 1); PG8_STAGE(PG8_SB(1, 0), b3, voffB);
            PG8_BAR; PG8_WAIT_L(0); PG8_MMA(0, 1, At, B1); PG8_BAR;
            PG8_LDA(At, 1, 1); PG8_STAGE(PG8_SA(1, 0), a3, voffA);
            PG8_BAR; PG8_WAIT_L(0); PG8_MMA(1, 0, At, B0); PG8_BAR; PG8_SCHED;
            PG8_STAGE(PG8_SB(1, 1), b3 + hstep, voffB);
            PG8_WAIT_V(6); PG8_BAR; PG8_MMA(1, 1, At, B1); PG8_BAR;
            }
        }
        if constexpr (ALIGN_EPI) { if (wr == 0) PG8_BAR; }
        if constexpr (!Epi::AFTER_DRAIN) { E(acc, cur, wr, wc, fr, fq); S.done(cur); }
        if (!has_next) break;
#pragma unroll
        for (int a = 0; a < 2; ++a)
#pragma unroll
            for (int b = 0; b < 2; ++b)
#pragma unroll
                for (int m = 0; m < 4; ++m)
#pragma unroll
                    for (int n = 0; n < 2; ++n) acc[a][b][m][n] = (f32x4){0.f, 0.f, 0.f, 0.f};
        cur = nxt; cA = nA; cB = nB; ++ui;
        if constexpr (ALIGN_EPI) { if (wr == 1) PG8_BAR; }
    }
    PG8_WAIT_V(0);
    if constexpr (!ALIGN_EPI) { if (wr == 0) PG8_BAR; }
    PG8_BAR;
    if constexpr (Epi::AFTER_DRAIN) { E.fused(acc, cur, wr, wc, fr, fq, lds, wid, lane); S.done(cur); }
#undef PG8_SA
#undef PG8_SB
#undef PG8_STAGE
#undef PG8_LDA
#undef PG8_LDB
#undef PG8_MMA
#undef PG8_WAIT_V
#undef PG8_WAIT_L
#undef PG8_BAR
#undef PG8_SCHED
}
}

#ifndef REP_GEMM
#define REP_GEMM 1
#endif
#ifndef REP_CONV
#define REP_CONV 1
#endif
#ifndef REP_ATTN
#define REP_ATTN 1
#endif
#ifndef REP_P0
#define REP_P0 1
#endif
#ifndef REP_SYNC
#define REP_SYNC 0
#endif
#ifndef REP_NORM4
#define REP_NORM4 1
#endif
#define GAS __attribute__((address_space(1)))
#define LAS __attribute__((address_space(3)))
typedef unsigned short bf16;
typedef unsigned v4u __attribute__((ext_vector_type(4)));
typedef unsigned v2u __attribute__((ext_vector_type(2)));
typedef float f32x4 __attribute__((ext_vector_type(4)));
typedef float f32x16 __attribute__((ext_vector_type(16)));
typedef short bf16x8 __attribute__((ext_vector_type(8)));
#define LDS_WAIT() asm volatile("s_waitcnt lgkmcnt(0)" ::: "memory")

constexpr int NWAVES = 8, NTHR = 512;
constexpr int BATCH = 8, SEQ = 2048, D = 1024, M = BATCH * SEQ, FF = 4096, NQKV = 1536, D3 = 3 * D;
constexpr float EPS = 1e-6f;
constexpr size_t MiB = 1u << 20;
constexpr size_t WS_WIN = 2 * MiB, WS_WHO = 8 * MiB, WS_WUP0 = 10 * MiB, WS_WUP1 = 18 * MiB, WS_WDN0 = 26 * MiB, WS_WDN1 = 34 * MiB, WS_WQKV = 42 * MiB, WS_WO = 45 * MiB;
constexpr size_t WS_ROPE = 47 * MiB;
constexpr size_t WS_KG = 48 * MiB;
constexpr size_t WS_XN = 64 * MiB;
constexpr size_t WS_MX = 96 * MiB;
constexpr size_t WS_BIG = 128 * MiB;
constexpr size_t WS_UT = WS_BIG, WS_Z = WS_BIG + 96 * MiB, WS_QKV = WS_BIG, WS_O = WS_BIG + 48 * MiB, WS_HB = WS_BIG;
constexpr size_t WS_END = 256 * MiB;
constexpr int LDS_BYTES = 147456;

__device__ __forceinline__ unsigned f2bf(float f) { unsigned u = __builtin_bit_cast(unsigned, f); return (u + 0x7fffu + ((u >> 16) & 1u)) >> 16; }
__device__ __forceinline__ unsigned pk2(float lo, float hi) { return f2bf(lo) | (f2bf(hi) << 16); }
__device__ __forceinline__ float bflo(unsigned w) { return __builtin_bit_cast(float, w << 16); }
__device__ __forceinline__ float bfhi(unsigned w) { return __builtin_bit_cast(float, w & 0xffff0000u); }
__device__ __forceinline__ float bf2f(unsigned short h) { return __builtin_bit_cast(float, (unsigned)h << 16); }
__device__ __forceinline__ float wave_sum(float v) {
#pragma unroll
    for (int o = 1; o < 64; o <<= 1) v += __shfl_xor(v, o);
    return v;
}

__device__ __forceinline__ float hw_sin(float x) { float r = x * 0.15915494309189535f; r -= floorf(r); return __builtin_amdgcn_sinf(r); }
__device__ __forceinline__ float hw_cos(float x) { float r = x * 0.15915494309189535f; r -= floorf(r); return __builtin_amdgcn_cosf(r); }
struct Frame {
    LAS unsigned char* lds;
    int tid, lane, wave, vcu, G;
};

__device__ __forceinline__ Frame relaunder(const Frame& F0) { Frame F = F0; int t = threadIdx.x; asm volatile("" : "+v"(t)); F.tid = t; F.lane = t & 63; F.wave = __builtin_amdgcn_readfirstlane(t >> 6); return F; }

#define XB_TMO      128
#define XB_XCNT(j)  (256  + 64 * (j))
#define XB_XSUB(j)  (1280 + 64 * (j))
#define XB_XGEN(j)  (2304 + 64 * (j))
#define XB_TOP      3328
#define XB_TOPGEN   3392
#define XCD_BAR_WORDS 3456
#define XB_SPIN_CAP (1u << 18)
__device__ __forceinline__ unsigned xb_ld(unsigned* p)              { return __hip_atomic_load(p, __ATOMIC_RELAXED, __HIP_MEMORY_SCOPE_AGENT); }
__device__ __forceinline__ unsigned xb_add(unsigned* p, unsigned v) { return __hip_atomic_fetch_add(p, v, __ATOMIC_RELAXED, __HIP_MEMORY_SCOPE_AGENT); }
__device__ __forceinline__ unsigned xb_xcc_id() { return (unsigned)__builtin_amdgcn_s_getreg((3 << 11) | 20) & 0xFu; }
#define XB_SPIN(cond, bar) do { unsigned _sp = 0; while (cond) { __builtin_amdgcn_s_sleep(1); \
    if ((++_sp & 255u) == 0u) { if (xb_ld(&(bar)[XB_TMO])) break; if (_sp > XB_SPIN_CAP) { atomicAdd(&(bar)[XB_TMO], 1u); break; } } } } while (0)
struct XcdBarrier { unsigned* bar; unsigned x; volatile LAS unsigned* st; };
__device__ __forceinline__ XcdBarrier xcd_barrier_post(unsigned* bar, volatile LAS unsigned* st) {
    XcdBarrier b; b.bar = bar; b.x = xb_xcc_id(); b.st = st;
    if (threadIdx.x == 0) (void)xb_add(&bar[XB_XCNT(b.x)], 1u);
    return b;
}
__device__ __forceinline__ void xcd_barrier_complete(unsigned* bar, unsigned x, unsigned& nloc, unsigned& nx) {
    const unsigned G = gridDim.x * gridDim.y * gridDim.z;
    unsigned sum, cnt, mine, sp = 0u;
    for (;;) {
        sum = 0u; cnt = 0u; mine = 0u;
#pragma unroll
        for (unsigned j = 0; j < 16; ++j) { const unsigned c = xb_ld(&bar[XB_XCNT(j)]); sum += c; cnt += (c > 0u) ? 1u : 0u; mine = (j == x) ? c : mine; }
        if (sum == G) break;
        __builtin_amdgcn_s_sleep(1);
        if ((++sp & 255u) == 0u) { if (xb_ld(&bar[XB_TMO])) break; if (sp > XB_SPIN_CAP) { atomicAdd(&bar[XB_TMO], 1u); break; } }
    }
    nloc = mine > 0u ? mine : 1u; nx = cnt > 0u ? cnt : 1u;
}
__device__ __forceinline__ void xcd_barrier(const XcdBarrier& b) {
    asm volatile("s_waitcnt vmcnt(0)" ::: "memory");
    __syncthreads();
    if (threadIdx.x == 0) {
        unsigned* bar = b.bar;
        __builtin_amdgcn_s_waitcnt(0);
        unsigned nloc = b.st[0], nx = b.st[1];
        if (nloc == 0u) { xcd_barrier_complete(bar, b.x, nloc, nx); b.st[0] = nloc; b.st[1] = nx; }
        const unsigned old = xb_add(&bar[XB_XSUB(b.x)], 1u);
        const unsigned gen = old / nloc;
        if (old + 1u == (gen + 1u) * nloc) {
            __builtin_amdgcn_fence(__ATOMIC_RELEASE, "agent");
            asm volatile("s_waitcnt vmcnt(0)" ::: "memory");
            const unsigned og = xb_add(&bar[XB_TOP], 1u);
            const unsigned tg = og / nx;
            if (og + 1u == (tg + 1u) * nx) xb_add(&bar[XB_TOPGEN], 1u);
            else XB_SPIN(xb_ld(&bar[XB_TOPGEN]) == tg, bar);
            __builtin_amdgcn_fence(__ATOMIC_ACQUIRE, "agent");
            xb_add(&bar[XB_XGEN(b.x)], 1u);
            asm volatile("s_waitcnt vmcnt(0)" ::: "memory");
        } else {
            XB_SPIN(xb_ld(&bar[XB_XGEN(b.x)]) == gen, bar);
            __builtin_amdgcn_fence(__ATOMIC_ACQUIRE, "agent");
            asm volatile("s_waitcnt vmcnt(0)" ::: "memory");
        }
    }
    __syncthreads();
}
__device__ __forceinline__ void p0_transpose_item(const float* W, int K, int N, bf16* WT, LAS float* scr, int item, int lane) {
    const int nblk = N / 32, kb = item / nblk, nb = item % nblk, k0 = 64 * kb, n0 = 32 * nb;
#pragma unroll 8
    for (int i = 0; i < 32; ++i) { const int kk = 2 * i + (lane >> 5); scr[kk * 33 + (lane & 31)] = W[(size_t)(k0 + kk) * N + n0 + (lane & 31)]; }
    LDS_WAIT(); asm volatile("" ::: "memory");
    const int c = lane & 7;
#pragma unroll
    for (int j = 0; j < 4; ++j) { const int n = (lane >> 3) + 8 * j; const LAS float* s = scr + (8 * c) * 33 + n;
        v4u o; o.x = pk2(s[0 * 33], s[1 * 33]); o.y = pk2(s[2 * 33], s[3 * 33]); o.z = pk2(s[4 * 33], s[5 * 33]); o.w = pk2(s[6 * 33], s[7 * 33]);
        *(GAS v4u*)(WT + (size_t)(n0 + n) * K + k0 + 8 * c) = o; }
    LDS_WAIT(); asm volatile("" ::: "memory");
}

__device__ __forceinline__ void rms_row_to_bf16(int lane, const float* xrow, const float* g, bf16* orow) {
    f32x4 v[2][2]; float s = 0.f;
#pragma unroll
    for (int j = 0; j < 2; ++j)
#pragma unroll
        for (int h = 0; h < 2; ++h) { v[j][h] = *(const GAS f32x4*)(xrow + 512 * j + 8 * lane + 4 * h); s += (v[j][h].x * v[j][h].x + v[j][h].y * v[j][h].y) + (v[j][h].z * v[j][h].z + v[j][h].w * v[j][h].w); }
    const float rstd = 1.f / sqrtf(wave_sum(s) * (1.f / D) + EPS);
#pragma unroll
    for (int j = 0; j < 2; ++j) {
        const f32x4 g0 = *(const GAS f32x4*)(g + 512 * j + 8 * lane), g1 = *(const GAS f32x4*)(g + 512 * j + 8 * lane + 4);
        const f32x4 a = v[j][0] * rstd * g0, b = v[j][1] * rstd * g1;
        v4u o; o.x = pk2(a.x, a.y); o.y = pk2(a.z, a.w); o.z = pk2(b.x, b.y); o.w = pk2(b.z, b.w);
        *(GAS v4u*)(orow + 512 * j + 8 * lane) = o; }
}

__device__ __forceinline__ void norm_pass(const Frame& F0, const float* res_in, float* res_out, const bf16* mx, const float* gpost, const float* gpre, bf16* xn) {
    const Frame F = relaunder(F0);
    const int gw = F.vcu * NWAVES + F.wave, NGW = F.G * NWAVES, lane = F.lane;
    for (int row = gw; row < M; row += NGW) {
        f32x4 mv[2][2], rv[2][2]; float s = 0.f;
#pragma unroll
        for (int j = 0; j < 2; ++j) {
            const v4u w = *(const GAS v4u*)(mx + (size_t)row * D + 512 * j + 8 * lane);
            mv[j][0] = (f32x4){bflo(w.x), bfhi(w.x), bflo(w.y), bfhi(w.y)}; mv[j][1] = (f32x4){bflo(w.z), bfhi(w.z), bflo(w.w), bfhi(w.w)};
#pragma unroll
            for (int h = 0; h < 2; ++h) { rv[j][h] = *(const GAS f32x4*)(res_in + (size_t)row * D + 512 * j + 8 * lane + 4 * h);
                s += (mv[j][h].x * mv[j][h].x + mv[j][h].y * mv[j][h].y) + (mv[j][h].z * mv[j][h].z + mv[j][h].w * mv[j][h].w); }
        }
        const float rstd = 1.f / sqrtf(wave_sum(s) * (1.f / D) + EPS);
        float s2 = 0.f;
#pragma unroll
        for (int j = 0; j < 2; ++j)
#pragma unroll
            for (int h = 0; h < 2; ++h) { const f32x4 g = *(const GAS f32x4*)(gpost + 512 * j + 8 * lane + 4 * h);
                const f32x4 hv = rv[j][h] + mv[j][h] * rstd * g; rv[j][h] = hv;
                *(GAS f32x4*)(res_out + (size_t)row * D + 512 * j + 8 * lane + 4 * h) = hv;
                s2 += (hv.x * hv.x + hv.y * hv.y) + (hv.z * hv.z + hv.w * hv.w); }
        if (xn) {
            const float rstd2 = 1.f / sqrtf(wave_sum(s2) * (1.f / D) + EPS);
#pragma unroll
            for (int j = 0; j < 2; ++j) {
                const f32x4 g0 = *(const GAS f32x4*)(gpre + 512 * j + 8 * lane), g1 = *(const GAS f32x4*)(gpre + 512 * j + 8 * lane + 4);
                const f32x4 a = rv[j][0] * rstd2 * g0, b = rv[j][1] * rstd2 * g1;
                v4u o; o.x = pk2(a.x, a.y); o.y = pk2(a.z, a.w); o.z = pk2(b.x, b.y); o.w = pk2(b.z, b.w);
                *(GAS v4u*)(xn + (size_t)row * D + 512 * j + 8 * lane) = o; }
        }
    }
}

__device__ __forceinline__ void filter_gen(const Frame& F0, const float* w1, const float* b1, const float* w2, const float* b2, const float* w3, const float* b3,
                                           const float* freq, const float* wout, bf16* KG) {
    const Frame F = relaunder(F0);
    LAS float* zf = (LAS float*)F.lds;
    LAS float* ha = zf + 8 * 36;
    LAS float* hb = ha + 8 * 64;
    LAS float* h3 = hb + 8 * 64;
    const int tid = F.tid;
    for (int tile = blockIdx.x; tile < SEQ / 8; tile += F.G) {
        const int t0 = tile * 8;
        if (tid < 8 * 33) { const int tt = tid / 33, e = tid % 33, t = t0 + tt; float v;
            if (e == 0) v = (float)t / (float)(SEQ - 1);
            else { const int bi = (e - 1) & 15; const float f = 1e-4f + (float)bi * ((15.0f - 1e-4f) / 15.0f); const float w = (6.283185307179586f / (float)SEQ) * (float)t; const float a = f * w;
                v = (e <= 16) ? hw_cos(a) : -hw_sin(a); }
            zf[tt * 36 + e] = v; }
        __syncthreads();
        const int tt = tid >> 6, k = tid & 63; const float fr = freq[k];
        { float s = b1[k];
#pragma unroll 3
          for (int e = 0; e < 33; ++e) s += zf[tt * 36 + e] * w1[e * 64 + k]; ha[tt * 64 + k] = hw_sin(fr * s); }
        __syncthreads();
        { float s = b2[k];
#pragma unroll 4
          for (int e = 0; e < 64; ++e) s += ha[tt * 64 + e] * w2[e * 64 + k]; hb[tt * 64 + k] = hw_sin(fr * s); }
        __syncthreads();
        { float s = b3[k];
#pragma unroll 4
          for (int e = 0; e < 64; ++e) s += hb[tt * 64 + e] * w3[e * 64 + k]; h3[k * 8 + tt] = hw_sin(fr * s); }
        __syncthreads();
        const float min_decay = -3.0701134573253945f, max_decay = -15.350567286626972f;
#pragma unroll 1
        for (int q = 0; q < 8; ++q) {
            const int col = tid + 512 * q;
            float acc[8];
#pragma unroll
            for (int i = 0; i < 8; ++i) acc[i] = 0.f;
#pragma unroll 4
            for (int kk = 0; kk < 64; ++kk) { const float w = wout[(size_t)kk * 4096 + col]; const f32x4 a = *(const LAS f32x4*)(h3 + kk * 8), b = *(const LAS f32x4*)(h3 + kk * 8 + 4);
                acc[0] += w * a.x; acc[1] += w * a.y; acc[2] += w * a.z; acc[3] += w * a.w; acc[4] += w * b.x; acc[5] += w * b.y; acc[6] += w * b.z; acc[7] += w * b.w; }
            const int dir = col >> 11, order = (col >> 10) & 1, c = col & 1023;
            const float delta = fabsf(min_decay + (max_decay - min_decay) * ((float)c / (float)(D - 1)));
            unsigned short hv[8];
#pragma unroll
            for (int i = 0; i < 8; ++i) { const float tn = (float)(t0 + i) / (float)(SEQ - 1); hv[i] = (unsigned short)f2bf(acc[i] * __expf(-tn * delta)); }
            bf16* dst = KG + (size_t)(order * 1024 + c) * 4096;
            if (dir == 0) {
#pragma unroll
                for (int i = 0; i < 8; ++i) dst[2048 - (t0 + i)] = hv[i];
            } else if (t0 == 0) {
                dst[0] = 0;
#pragma unroll
                for (int i = 1; i < 8; ++i) dst[2048 + i] = hv[i];
            } else {
                v4u o; o.x = hv[0] | ((unsigned)hv[1] << 16); o.y = hv[2] | ((unsigned)hv[3] << 16); o.z = hv[4] | ((unsigned)hv[5] << 16); o.w = hv[6] | ((unsigned)hv[7] << 16);
                *(GAS v4u*)(dst + 2048 + t0) = o;
            }
        }
        __syncthreads();
    }
}

constexpr int UPB = 4880;
constexpr int CV_UB = 0, CV_XB = 8 * UPB, CV_KF = CV_XB + 8 * 4096, KFS = 8224, CV_END = CV_KF + 8 * KFS;
static_assert(CV_END <= LDS_BYTES, "conv LDS map");

__device__ __forceinline__ void cv_stage_stream(const Frame& F, const bf16* src, float w0, float w1, float w2, float bb, LAS unsigned char* dst, int rs, int eo) {
#pragma unroll
    for (int j = 0; j < 4; ++j) {
        const int id = F.tid + 512 * j, b = id >> 8, t8 = (id & 255) * 8;
        const bf16* p = src + b * 2048 + t8;
        const v4u w = *(const GAS v4u*)p;
        const float prev = (t8 > 0) ? bf2f(p[-1]) : 0.f, next = (t8 + 8 < 2048) ? bf2f(p[8]) : 0.f;
        float u[10]; u[0] = prev; u[1] = bflo(w.x); u[2] = bfhi(w.x); u[3] = bflo(w.y); u[4] = bfhi(w.y); u[5] = bflo(w.z); u[6] = bfhi(w.z); u[7] = bflo(w.w); u[8] = bfhi(w.w); u[9] = next;
        float o[8];
#pragma unroll
        for (int i = 0; i < 8; ++i) o[i] = w0 * u[i] + w1 * u[i + 1] + w2 * u[i + 2] + bb;
        v4u r; r.x = pk2(o[0], o[1]); r.y = pk2(o[2], o[3]); r.z = pk2(o[4], o[5]); r.w = pk2(o[6], o[7]);
        *(LAS v4u*)(dst + b * rs + (eo + t8) * 2) = r;
    }
}
__device__ __forceinline__ void cv_stage_filter(const Frame& F, const bf16* kg) {
    const int w = F.tid;
    v4u lo = (v4u){0u, 0u, 0u, 0u}, hi4;
    if (w > 0) lo = *(const GAS v4u*)(kg + 8 * (w - 1));
    hi4 = *(const GAS v4u*)(kg + 8 * w);
    const unsigned Dw[8] = {lo.x, lo.y, lo.z, lo.w, hi4.x, hi4.y, hi4.z, hi4.w};
    LAS unsigned char* base = F.lds + CV_KF + w * 16;
#pragma unroll
    for (int q = 0; q < 8; ++q) {
        v4u o;
        if ((q & 1) == 0) { const int s = (8 - q) / 2; o.x = Dw[s & 7]; o.y = Dw[(s + 1) & 7]; o.z = Dw[(s + 2) & 7]; o.w = Dw[(s + 3) & 7]; }
        else { const int s = (7 - q) / 2;
            o.x = __builtin_amdgcn_alignbit(Dw[s + 1], Dw[s], 16); o.y = __builtin_amdgcn_alignbit(Dw[s + 2], Dw[s + 1], 16);
            o.z = __builtin_amdgcn_alignbit(Dw[s + 3], Dw[s + 2], 16); o.w = __builtin_amdgcn_alignbit(Dw[s + 4], Dw[s + 3], 16); }
        *(LAS v4u*)(base + q * KFS) = o;
    }
}
__device__ __forceinline__ void cv_mfma_loop(const Frame& F, f32x16 (&acc)[2]) {
    const int lane = F.lane, hi = lane >> 5, i = lane & 31, tau = F.wave;
    const int d0 = 4 * tau - 31;
    unsigned aaddr = CV_KF + (i & 7) * KFS + (256 + hi - (i >> 3)) * 16 - 128 * d0;
    unsigned baddr = CV_UB + (i & 7) * UPB + (192 + 64 * (4 * tau + (i >> 3)) + 8 * hi) * 2 - 128 * d0;
#pragma unroll
    for (int e = 0; e < 16; ++e) { acc[0][e] = 0.f; acc[1][e] = 0.f; }
    for (int s = 0; s < 35; ++s) {
        bf16x8 Af[6], Bf[4];
#pragma unroll
        for (int u = 0; u < 6; ++u) Af[u] = *(const LAS bf16x8*)(F.lds + aaddr + 32 * (u - 2));
#pragma unroll
        for (int ks = 0; ks < 4; ++ks) Bf[ks] = *(const LAS bf16x8*)(F.lds + baddr + 32 * ks);
#pragma unroll
        for (int ks = 0; ks < 4; ++ks) {
            acc[0] = __builtin_amdgcn_mfma_f32_32x32x16_bf16(Af[ks + 2], Bf[ks], acc[0], 0, 0, 0);
            acc[1] = __builtin_amdgcn_mfma_f32_32x32x16_bf16(Af[ks], Bf[ks], acc[1], 0, 0, 0);
        }
        aaddr -= 128; baddr -= 128;
    }
}

__device__ __forceinline__ void conv_phase(const Frame& F0, const bf16* UT, const bf16* KG, const float* cw, const float* cb, const float* hbias, bf16* Z) {
    const Frame F = relaunder(F0);
    const int lane = F.lane, hi = lane >> 5, n = lane & 31, r = n >> 3, b = n & 7, tau = F.wave;
    for (int o = F.tid * 16; o < 8 * UPB; o += NTHR * 16) *(LAS v4u*)(F.lds + CV_UB + o) = (v4u){0u, 0u, 0u, 0u};
    __syncthreads();
    for (int vg = F.vcu; vg < D / 4; vg += F.G) {
        unsigned zo[2][4][4][2];
#pragma unroll
        for (int a = 0; a < 2; ++a)
#pragma unroll
            for (int g = 0; g < 4; ++g)
#pragma unroll
                for (int e = 0; e < 4; ++e) { zo[a][g][e][0] = 0u; zo[a][g][e][1] = 0u; }
        for (int cc = 0; cc < 4; ++cc) {
            const int c = vg * 4 + cc;
            cv_stage_stream(F, UT + (size_t)c * M, cw[c], cw[D3 + c], cw[2 * D3 + c], cb[c], F.lds + CV_UB, UPB, 192);
            cv_stage_stream(F, UT + (size_t)(D + c) * M, cw[D + c], cw[D3 + D + c], cw[2 * D3 + D + c], cb[D + c], F.lds + CV_XB, 4096, 0);
            cv_stage_filter(F, KG + (size_t)c * 4096);
            __syncthreads();
            f32x16 acc[2];
            cv_mfma_loop(F, acc);
            const float bias0 = hbias[c], bias1 = hbias[D + c];
            v2u zt[2][4];
#pragma unroll
            for (int mi = 0; mi < 2; ++mi)
#pragma unroll
                for (int g = 0; g < 4; ++g) {
                    const int t = 64 * (4 * tau + r) + 32 * mi + 8 * g + 4 * hi;
                    const v2u vv = *(const LAS v2u*)(F.lds + CV_UB + b * UPB + (192 + t) * 2), xx = *(const LAS v2u*)(F.lds + CV_XB + b * 4096 + t * 2);
                    const float z0 = bflo(xx.x) * (acc[mi][4 * g + 0] + bias0 * bflo(vv.x)), z1 = bfhi(xx.x) * (acc[mi][4 * g + 1] + bias0 * bfhi(vv.x));
                    const float z2 = bflo(xx.y) * (acc[mi][4 * g + 2] + bias0 * bflo(vv.y)), z3 = bfhi(xx.y) * (acc[mi][4 * g + 3] + bias0 * bfhi(vv.y));
                    zt[mi][g].x = pk2(z0, z1); zt[mi][g].y = pk2(z2, z3);
                }
            __syncthreads();
#pragma unroll
            for (int mi = 0; mi < 2; ++mi)
#pragma unroll
                for (int g = 0; g < 4; ++g) { const int t = 64 * (4 * tau + r) + 32 * mi + 8 * g + 4 * hi; *(LAS v2u*)(F.lds + CV_UB + b * UPB + (192 + t) * 2) = zt[mi][g]; }
            cv_stage_stream(F, UT + (size_t)(2 * D + c) * M, cw[2 * D + c], cw[D3 + 2 * D + c], cw[2 * D3 + 2 * D + c], cb[2 * D + c], F.lds + CV_XB, 4096, 0);
            cv_stage_filter(F, KG + (size_t)(D + c) * 4096);
            __syncthreads();
            cv_mfma_loop(F, acc);
#pragma unroll
            for (int mi = 0; mi < 2; ++mi)
#pragma unroll
                for (int g = 0; g < 4; ++g) {
                    const int t = 64 * (4 * tau + r) + 32 * mi + 8 * g + 4 * hi;
                    const v2u vv = *(const LAS v2u*)(F.lds + CV_UB + b * UPB + (192 + t) * 2), xx = *(const LAS v2u*)(F.lds + CV_XB + b * 4096 + t * 2);
                    float z[4];
                    z[0] = bflo(xx.x) * (acc[mi][4 * g + 0] + bias1 * bflo(vv.x)); z[1] = bfhi(xx.x) * (acc[mi][4 * g + 1] + bias1 * bfhi(vv.x));
                    z[2] = bflo(xx.y) * (acc[mi][4 * g + 2] + bias1 * bflo(vv.y)); z[3] = bfhi(xx.y) * (acc[mi][4 * g + 3] + bias1 * bfhi(vv.y));
#pragma unroll
                    for (int e = 0; e < 4; ++e) {
                        const unsigned hb16 = f2bf(z[e]);
                        const unsigned sh = (cc & 1) ? (hb16 << 16) : hb16;
                        const unsigned m0 = zo[mi][g][e][0] | sh, m1 = zo[mi][g][e][1] | sh;
                        zo[mi][g][e][0] = (cc < 2) ? m0 : zo[mi][g][e][0];
                        zo[mi][g][e][1] = (cc < 2) ? zo[mi][g][e][1] : m1;
                    }
                }
            __syncthreads();
        }
#pragma unroll
        for (int mi = 0; mi < 2; ++mi)
#pragma unroll
            for (int g = 0; g < 4; ++g)
#pragma unroll
                for (int e = 0; e < 4; ++e) {
                    const int t = 64 * (4 * tau + r) + 32 * mi + 8 * g + 4 * hi + e;
                    v2u o; o.x = zo[mi][g][e][0]; o.y = zo[mi][g][e][1];
                    *(GAS v2u*)(Z + (size_t)(b * SEQ + t) * D + vg * 4) = o;
                }
    }
}

constexpr int KROW = 144, VROW = 784, AT_K = 0, AT_V = 384 * KROW, AT_END = AT_V + 64 * VROW;
static_assert(AT_END <= LDS_BYTES, "attention LDS map");

__device__ __forceinline__ void attn_phase(const Frame& F0, const bf16* QKV, const float* rope, const float* sink, bf16* O) {
    const Frame F = relaunder(F0);
    const int lane = F.lane, hi = lane >> 5, iq = lane & 31, w = F.wave, g = w >> 1, half = w & 1;
    for (int u = blockIdx.x; u < BATCH * 16 * 4; u += F.G) {
        const int kvh = u & 3, nb = (u >> 2) & 15, bb = u >> 6;
#pragma unroll
        for (int j = 0; j < 3; ++j) {
            const int id = F.tid + 512 * j, key = id >> 2, p = id & 3;
            const int kpos = (nb - 1) * 128 + key;
            v4u c0 = (v4u){0u, 0u, 0u, 0u}, c1 = c0;
            if (kpos >= 0 && kpos < SEQ) {
                const bf16* src = QKV + (size_t)(bb * SEQ + kpos) * NQKV + 1024 + kvh * 64 + 16 * p;
                c0 = *(const GAS v4u*)src; c1 = *(const GAS v4u*)(src + 8);
                if (p == 0) {
                    const f32x4 cA = *(const GAS f32x4*)(rope + kpos * 16), cB = *(const GAS f32x4*)(rope + kpos * 16 + 4), sA = *(const GAS f32x4*)(rope + kpos * 16 + 8), sB = *(const GAS f32x4*)(rope + kpos * 16 + 12);
                    const float cs[8] = {cA.x, cA.y, cA.z, cA.w, cB.x, cB.y, cB.z, cB.w}, sn[8] = {sA.x, sA.y, sA.z, sA.w, sB.x, sB.y, sB.z, sB.w};
                    const unsigned aw[4] = {c0.x, c0.y, c0.z, c0.w}, bw[4] = {c1.x, c1.y, c1.z, c1.w};
                    unsigned ao[4], bo[4];
#pragma unroll
                    for (int e = 0; e < 4; ++e) {
                        const float a0 = bflo(aw[e]), a1 = bfhi(aw[e]), b0 = bflo(bw[e]), b1 = bfhi(bw[e]);
                        ao[e] = pk2(a0 * cs[2 * e] - b0 * sn[2 * e], a1 * cs[2 * e + 1] - b1 * sn[2 * e + 1]);
                        bo[e] = pk2(b0 * cs[2 * e] + a0 * sn[2 * e], b1 * cs[2 * e + 1] + a1 * sn[2 * e + 1]);
                    }
                    c0 = (v4u){ao[0], ao[1], ao[2], ao[3]}; c1 = (v4u){bo[0], bo[1], bo[2], bo[3]};
                }
            }
            *(LAS v4u*)(F.lds + AT_K + key * KROW + 32 * p) = c0; *(LAS v4u*)(F.lds + AT_K + key * KROW + 32 * p + 16) = c1;
        }
#pragma unroll
        for (int j = 0; j < 6; ++j) {
            const int id = F.tid + 512 * j, key = id % 384, ch = id / 384;
            const int kpos = (nb - 1) * 128 + key;
            v4u c0 = (v4u){0u, 0u, 0u, 0u};
            if (kpos >= 0 && kpos < SEQ) c0 = *(const GAS v4u*)(QKV + (size_t)(bb * SEQ + kpos) * NQKV + 1280 + kvh * 64 + 8 * ch);
            const unsigned cw4[4] = {c0.x, c0.y, c0.z, c0.w};
#pragma unroll
            for (int e = 0; e < 4; ++e) {
                *(LAS unsigned short*)(F.lds + AT_V + (8 * ch + 2 * e) * VROW + key * 2) = (unsigned short)(cw4[e] & 0xffffu);
                *(LAS unsigned short*)(F.lds + AT_V + (8 * ch + 2 * e + 1) * VROW + key * 2) = (unsigned short)(cw4[e] >> 16);
            }
        }
        __syncthreads();
        const int hq = kvh * 4 + g;
        const float sk = sink[hq];
#pragma unroll 1
        for (int qt = 0; qt < 2; ++qt) {
            const int qi = 64 * half + 32 * qt + iq, qpos = nb * 128 + qi;
            const bf16* qsrc = QKV + (size_t)(bb * SEQ + qpos) * NQKV + hq * 64;
            bf16x8 Qf[4];
            {
                const v4u ca = *(const GAS v4u*)qsrc, cbv = *(const GAS v4u*)(qsrc + 8);
                const f32x4 cA = *(const GAS f32x4*)(rope + qpos * 16), cB = *(const GAS f32x4*)(rope + qpos * 16 + 4), sA = *(const GAS f32x4*)(rope + qpos * 16 + 8), sB = *(const GAS f32x4*)(rope + qpos * 16 + 12);
                const float cs[8] = {cA.x, cA.y, cA.z, cA.w, cB.x, cB.y, cB.z, cB.w}, sn[8] = {sA.x, sA.y, sA.z, sA.w, sB.x, sB.y, sB.z, sB.w};
                const unsigned aw[4] = {ca.x, ca.y, ca.z, ca.w}, bw[4] = {cbv.x, cbv.y, cbv.z, cbv.w};
                unsigned oo[4];
#pragma unroll
                for (int e = 0; e < 4; ++e) {
                    const float a0 = bflo(aw[e]), a1 = bfhi(aw[e]), b0 = bflo(bw[e]), b1 = bfhi(bw[e]);
                    const float r0 = hi ? (b0 * cs[2 * e] + a0 * sn[2 * e]) : (a0 * cs[2 * e] - b0 * sn[2 * e]);
                    const float r1 = hi ? (b1 * cs[2 * e + 1] + a1 * sn[2 * e + 1]) : (a1 * cs[2 * e + 1] - b1 * sn[2 * e + 1]);
                    oo[e] = pk2(r0, r1);
                }
                Qf[0] = __builtin_bit_cast(bf16x8, (v4u){oo[0], oo[1], oo[2], oo[3]});
            }
#pragma unroll
            for (int ks = 1; ks < 4; ++ks) Qf[ks] = *(const GAS bf16x8*)(qsrc + 16 * ks + 8 * hi);
            f32x16 Oa[2];
#pragma unroll
            for (int e = 0; e < 16; ++e) { Oa[0][e] = 0.f; Oa[1][e] = 0.f; }
            float mrun = sk, lrun = hi ? 0.f : 1.f;
            const int kt0 = 2 * half + qt;
#pragma unroll 1
            for (int j = 0; j < 9; ++j) {
                const int kt = kt0 + j;
                if ((nb == 0 && kt < 4) || (nb == 15 && kt >= 8)) continue;
                f32x16 S;
#pragma unroll
                for (int e = 0; e < 16; ++e) S[e] = 0.f;
#pragma unroll
                for (int ks = 0; ks < 4; ++ks) {
                    const bf16x8 Kf = *(const LAS bf16x8*)(F.lds + AT_K + (32 * kt + iq) * KROW + (16 * ks + 8 * hi) * 2);
                    S = __builtin_amdgcn_mfma_f32_32x32x16_bf16(Kf, Qf[ks], S, 0, 0, 0);
                }
                float tmax = -3.0e38f;
#pragma unroll
                for (int e = 0; e < 16; ++e) {
                    const int jj = 8 * (e >> 2) + 4 * hi + (e & 3);
                    float s = S[e] * 0.125f;
                    if (j == 0 && jj < iq) s = -3.0e38f;
                    if (j == 8 && jj > iq) s = -3.0e38f;
                    S[e] = s; tmax = fmaxf(tmax, s);
                }
                tmax = fmaxf(tmax, __shfl_xor(tmax, 32));
                const float mnew = fmaxf(mrun, tmax), alpha = __expf(mrun - mnew);
                float ps = 0.f;
#pragma unroll
                for (int e = 0; e < 16; ++e) { const float p = __expf(S[e] - mnew); S[e] = p; ps += p; }
                lrun = lrun * alpha + ps; mrun = mnew;
#pragma unroll
                for (int e = 0; e < 16; ++e) { Oa[0][e] *= alpha; Oa[1][e] *= alpha; }
#pragma unroll
                for (int s2 = 0; s2 < 2; ++s2) {
                    const bf16x8 Pf = __builtin_bit_cast(bf16x8, (v4u){pk2(S[8 * s2 + 0], S[8 * s2 + 1]), pk2(S[8 * s2 + 2], S[8 * s2 + 3]), pk2(S[8 * s2 + 4], S[8 * s2 + 5]), pk2(S[8 * s2 + 6], S[8 * s2 + 7])});
#pragma unroll
                    for (int mt = 0; mt < 2; ++mt) {
                        const LAS unsigned char* vp = F.lds + AT_V + (32 * mt + iq) * VROW + (32 * kt + 16 * s2 + 4 * hi) * 2;
                        const v2u v0 = *(const LAS v2u*)vp, v1 = *(const LAS v2u*)(vp + 16);
                        const bf16x8 Vf = __builtin_bit_cast(bf16x8, (v4u){v0.x, v0.y, v1.x, v1.y});
                        Oa[mt] = __builtin_amdgcn_mfma_f32_32x32x16_bf16(Vf, Pf, Oa[mt], 0, 0, 0);
                    }
                }
            }
            const float ltot = lrun + __shfl_xor(lrun, 32), inv = 1.f / ltot;
            bf16* orow = O + (size_t)(bb * SEQ + qpos) * D + hq * 64;
#pragma unroll
            for (int mt = 0; mt < 2; ++mt)
#pragma unroll
                for (int gq = 0; gq < 4; ++gq) {
                    v2u o; o.x = pk2(Oa[mt][4 * gq + 0] * inv, Oa[mt][4 * gq + 1] * inv); o.y = pk2(Oa[mt][4 * gq + 2] * inv, Oa[mt][4 * gq + 3] * inv);
                    *(GAS v2u*)(orow + 32 * mt + 8 * gq + 4 * hi) = o;
                }
        }
        __syncthreads();
    }
}

struct Args { const float* in[23]; float* out; unsigned char* ws; };
__global__ void __launch_bounds__(NTHR, 2) hybrid_fwd(Args args) {
    extern __shared__ __attribute__((aligned(16))) unsigned char lds_raw[];
    cg::grid_group grid = cg::this_grid();
    Frame F;
    F.lds = (LAS unsigned char*)lds_raw;
    F.tid = threadIdx.x; F.lane = F.tid & 63; F.wave = __builtin_amdgcn_readfirstlane(F.tid >> 6);
    F.G = gridDim.x; { const int bx = blockIdx.x; F.vcu = (F.G % 8 == 0) ? (bx % 8) * (F.G / 8) + bx / 8 : bx; }
    unsigned char* ws = args.ws;
    const float* x = args.in[0];
    const float *g_mix_pre = args.in[1], *g_mix_post = args.in[2], *g_mlp_pre = args.in[3], *g_mlp_post = args.in[4];
    bf16 *Wt_in = (bf16*)(ws + WS_WIN), *Wt_ho = (bf16*)(ws + WS_WHO), *Wt_up0 = (bf16*)(ws + WS_WUP0), *Wt_up1 = (bf16*)(ws + WS_WUP1), *Wt_dn0 = (bf16*)(ws + WS_WDN0), *Wt_dn1 = (bf16*)(ws + WS_WDN1),
         *Wt_qkv = (bf16*)(ws + WS_WQKV), *Wt_o = (bf16*)(ws + WS_WO);
    float* rope = (float*)(ws + WS_ROPE);
    bf16 *KG = (bf16*)(ws + WS_KG), *XN = (bf16*)(ws + WS_XN), *MX = (bf16*)(ws + WS_MX), *UT = (bf16*)(ws + WS_UT), *Zb = (bf16*)(ws + WS_Z), *QKV = (bf16*)(ws + WS_QKV), *Ob = (bf16*)(ws + WS_O), *HB = (bf16*)(ws + WS_HB);
    float* hres = args.out;
    unsigned* barw = (unsigned*)ws;
    if (blockIdx.x == 0) for (int i = F.tid; i < XCD_BAR_WORDS; i += NTHR) barw[i] = 0u;
    volatile LAS unsigned* xst = (volatile LAS unsigned*)(F.lds + LDS_BYTES - 16);
    if (F.tid < 4) xst[F.tid] = 0u;
    __syncthreads();

    for (int rep0_ = 0; rep0_ < REP_P0; ++rep0_) {
#ifndef NO_FG
    filter_gen(F, args.in[10], args.in[11], args.in[12], args.in[13], args.in[14], args.in[15], args.in[16], args.in[17], KG);
#endif
    {
        const int gt = blockIdx.x * NTHR + F.tid;
        for (int id = gt; id < SEQ * 8; id += F.G * NTHR) { const int pos = id >> 3, i = id & 7;
            const float inv = __expf(-(float)i * (13.122363377404328f / 8.0f)); const float ang = (float)pos * inv;
            rope[pos * 16 + i] = hw_cos(ang); rope[pos * 16 + 8 + i] = hw_sin(ang); }
    }
    {
        LAS float* scr = (LAS float*)(F.lds + F.wave * 16384);
        const int gw = F.vcu * NWAVES + F.wave, NGW = F.G * NWAVES;
        constexpr int I_IN = 16 * 96, I_HO = 16 * 32, I_UP = 16 * 128, I_DN = 64 * 32, I_QKV = 16 * 48, I_O = 16 * 32;
        constexpr int NITEMS = I_IN + I_HO + 2 * I_UP + 2 * I_DN + I_QKV + I_O;
        for (int it = gw; it < NITEMS; it += NGW) {
            int r = it;
            if (r < I_IN) { p0_transpose_item(args.in[7], D, D3, Wt_in, scr, r, F.lane); continue; } r -= I_IN;
            if (r < I_HO) { p0_transpose_item(args.in[19], D, D, Wt_ho, scr, r, F.lane); continue; } r -= I_HO;
            if (r < I_UP) { p0_transpose_item(args.in[5], D, FF, Wt_up0, scr, r, F.lane); continue; } r -= I_UP;
            if (r < I_UP) { p0_transpose_item(args.in[5] + (size_t)D * FF, D, FF, Wt_up1, scr, r, F.lane); continue; } r -= I_UP;
            if (r < I_DN) { p0_transpose_item(args.in[6], FF, D, Wt_dn0, scr, r, F.lane); continue; } r -= I_DN;
            if (r < I_DN) { p0_transpose_item(args.in[6] + (size_t)D * FF, FF, D, Wt_dn1, scr, r, F.lane); continue; } r -= I_DN;
            if (r < I_QKV) { p0_transpose_item(args.in[20], D, NQKV, Wt_qkv, scr, r, F.lane); continue; } r -= I_QKV;
            p0_transpose_item(args.in[22], D, D, Wt_o, scr, r, F.lane);
        }
        for (int m = gw; m < M; m += NGW) rms_row_to_bf16(F.lane, x + (size_t)m * D, g_mix_pre, XN + (size_t)m * D);
    }
    __syncthreads();
    }
    grid.sync();
    const XcdBarrier xbar = xcd_barrier_post(barw, xst);
    { pg8::Gemm g{Wt_in, XN, D3, M, D}; pg8::StaticOrder S; S.init(D3, M, F.G, (int)blockIdx.x); pg8::EpiBf16<0> E{UT, M};
      for (int rep_ = 0; rep_ < REP_GEMM; ++rep_)
      pg8::gemm_phase<pg8::EpiBf16<0>, pg8::StaticOrder, true, true>(F.lds, g, S, E); }
    xcd_barrier(xbar);
#ifndef NO_CONV
    for (int rep_ = 0; rep_ < REP_CONV; ++rep_)
    conv_phase(F, UT, KG, args.in[8], args.in[9], args.in[18], Zb);
#endif
    xcd_barrier(xbar);
    { pg8::Gemm g{Zb, Wt_ho, M, D, D}; pg8::StaticOrder S; S.init(M, D, F.G, (int)blockIdx.x); pg8::EpiBf16<0> E{MX, D};
      for (int rep_ = 0; rep_ < REP_GEMM; ++rep_)
      pg8::gemm_phase<pg8::EpiBf16<0>, pg8::StaticOrder, true, true>(F.lds, g, S, E); }
    xcd_barrier(xbar);
    for (int rep_ = 0; rep_ < REP_NORM4; ++rep_)
    norm_pass(F, x, hres, MX, g_mix_post, g_mlp_pre, XN);
    for (int rep_ = 0; rep_ < REP_SYNC; ++rep_) xcd_barrier(xbar);
    xcd_barrier(xbar);
    { pg8::Gemm g{XN, Wt_up0, M, FF, D}; pg8::StaticOrder S; S.init(M, FF, F.G, (int)blockIdx.x); pg8::EpiBf16<2> E{HB, FF};
      for (int rep_ = 0; rep_ < REP_GEMM; ++rep_)
      pg8::gemm_phase<pg8::EpiBf16<2>, pg8::StaticOrder, true, true>(F.lds, g, S, E); }
    xcd_barrier(xbar);
    { pg8::Gemm g{HB, Wt_dn0, M, D, FF}; pg8::StaticOrder S; S.init(M, D, F.G, (int)blockIdx.x); pg8::EpiBf16<0> E{MX, D};
      for (int rep_ = 0; rep_ < REP_GEMM; ++rep_)
      pg8::gemm_phase<pg8::EpiBf16<0>, pg8::StaticOrder, true, true>(F.lds, g, S, E); }
    xcd_barrier(xbar);
    norm_pass(F, hres, hres, MX, g_mlp_post, g_mix_pre + D, XN);
    xcd_barrier(xbar);
    { pg8::Gemm g{XN, Wt_qkv, M, NQKV, D}; pg8::StaticOrder S; S.init(M, NQKV, F.G, (int)blockIdx.x); pg8::EpiBf16<0> E{QKV, NQKV};
      for (int rep_ = 0; rep_ < REP_GEMM; ++rep_)
      pg8::gemm_phase<pg8::EpiBf16<0>, pg8::StaticOrder, true, true>(F.lds, g, S, E); }
    xcd_barrier(xbar);
#ifndef NO_ATTN
    for (int rep_ = 0; rep_ < REP_ATTN; ++rep_)
    attn_phase(F, QKV, rope, args.in[21], Ob);
#endif
    xcd_barrier(xbar);
    { pg8::Gemm g{Ob, Wt_o, M, D, D}; pg8::StaticOrder S; S.init(M, D, F.G, (int)blockIdx.x); pg8::EpiBf16<0> E{MX, D};
      for (int rep_ = 0; rep_ < REP_GEMM; ++rep_)
      pg8::gemm_phase<pg8::EpiBf16<0>, pg8::StaticOrder, true, true>(F.lds, g, S, E); }
    xcd_barrier(xbar);
    norm_pass(F, hres, hres, MX, g_mix_post + D, g_mlp_pre + D, XN);
    xcd_barrier(xbar);
    { pg8::Gemm g{XN, Wt_up1, M, FF, D}; pg8::StaticOrder S; S.init(M, FF, F.G, (int)blockIdx.x); pg8::EpiBf16<2> E{HB, FF};
      for (int rep_ = 0; rep_ < REP_GEMM; ++rep_)
      pg8::gemm_phase<pg8::EpiBf16<2>, pg8::StaticOrder, true, true>(F.lds, g, S, E); }
    xcd_barrier(xbar);
    { pg8::Gemm g{HB, Wt_dn1, M, D, FF}; pg8::StaticOrder S; S.init(M, D, F.G, (int)blockIdx.x); pg8::EpiBf16<0> E{MX, D};
      for (int rep_ = 0; rep_ < REP_GEMM; ++rep_)
      pg8::gemm_phase<pg8::EpiBf16<0>, pg8::StaticOrder, true, true>(F.lds, g, S, E); }
    xcd_barrier(xbar);
    norm_pass(F, hres, hres, MX, g_mlp_post + D, nullptr, nullptr);
}

extern "C" void kernel_launch(void* const* d_in, const int* in_sizes, int n_in, void* d_out, int out_size, void* d_ws, size_t ws_size, hipStream_t stream) {
    static int grid = 0;
    if (grid == 0) {
        if (n_in != 23 || out_size != M * D || ws_size < WS_END) { fprintf(stderr, "kernel_launch: unexpected shapes (n_in %d out %d ws %zu)\n", n_in, out_size, ws_size); grid = -1; return; }
        int dev = 0, cus = 0, per_cu = 0;
        if (hipGetDevice(&dev) != hipSuccess || hipDeviceGetAttribute(&cus, hipDeviceAttributeMultiprocessorCount, dev) != hipSuccess) { grid = -1; return; }
        if (hipFuncSetAttribute((const void*)hybrid_fwd, hipFuncAttributeMaxDynamicSharedMemorySize, LDS_BYTES) != hipSuccess) { fprintf(stderr, "kernel_launch: hipFuncSetAttribute failed\n"); grid = -1; return; }
        if (hipOccupancyMaxActiveBlocksPerMultiprocessor(&per_cu, (const void*)hybrid_fwd, NTHR, LDS_BYTES) != hipSuccess || per_cu < 1) { fprintf(stderr, "kernel_launch: occupancy query says %d\n", per_cu); per_cu = 1; }
        (void)hipGetLastError();
        grid = cus * per_cu;
    }
    if (grid < 0) return;
    Args a{};
    for (int i = 0; i < 23; ++i) a.in[i] = (const float*)d_in[i];
    a.out = (float*)d_out; a.ws = (unsigned char*)d_ws;
    void* kargs[] = {&a};
    const hipError_t e = hipLaunchCooperativeKernel((const void*)hybrid_fwd, dim3(grid), dim3(NTHR), kargs, LDS_BYTES, stream);
    if (e != hipSuccess) fprintf(stderr, "kernel_launch: cooperative launch failed: %s (grid %d)\n", hipGetErrorString(e), grid);
}
```
